# Optimizing an MI355X kernel written in HIP

```python
import jax, jax.numpy as jnp
from jax import lax
import numpy as np

D_MODEL = 1024
BATCH = 4
SEQ = 8192
DEPTH = 1

HEAD_DIM = 64
ATTN_WIDTH = 3 * D_MODEL // 4
N_ATTN_HEADS = ATTN_WIDTH // HEAD_DIM
CONV_WIDTH = D_MODEL - ATTN_WIDTH
MIX_WIDTH = ATTN_WIDTH + CONV_WIDTH
IN_WIDTH = 4 * ATTN_WIDTH + 4 * CONV_WIDTH
CONV_K = 3
DILATED_PATTERNS = ((128, 1), (512, 4), (2048, 16))
BLOCK = 128
ROPE_THETA = 10000.0
NORM_EPS = 1e-6

kernel_name = "hybrid_dilated_attn_shortconv_layer"


def rmsnorm(x, g):
    xf = x.astype(jnp.float32)
    y = xf * lax.rsqrt(jnp.mean(xf * xf, axis=-1, keepdims=True) + NORM_EPS)
    return (y * g.astype(jnp.float32)).astype(x.dtype)


def rope(t, pos):
    half = t.shape[-1] // 2
    inv_freq = ROPE_THETA ** (-jnp.arange(half, dtype=jnp.float32) * 2.0 / t.shape[-1])
    ang = pos.astype(jnp.float32)[:, None] * inv_freq[None, :]
    cos = jnp.cos(ang)[None, :, None, :]
    sin = jnp.sin(ang)[None, :, None, :]
    tf = t.astype(jnp.float32)
    t1, t2 = tf[..., :half], tf[..., half:]
    out = jnp.concatenate([t1 * cos - t2 * sin, t2 * cos + t1 * sin], axis=-1)
    return out.astype(t.dtype)


def banded_window_attn(q, k, v, window_keys):
    N, L, H, hd = q.shape
    Lp = -(-L // BLOCK) * BLOCK
    padw = ((0, 0), (0, Lp - L), (0, 0), (0, 0))
    q, k, v = jnp.pad(q, padw), jnp.pad(k, padw), jnp.pad(v, padw)
    nb = Lp // BLOCK
    qb = q.reshape(N, nb, BLOCK, H, hd)
    kb = k.reshape(N, nb, BLOCK, H, hd)
    vb = v.reshape(N, nb, BLOCK, H, hd)
    shift = ((0, 0), (1, 0), (0, 0), (0, 0), (0, 0))
    kk = jnp.concatenate([jnp.pad(kb, shift)[:, :-1], kb], axis=2)
    vv = jnp.concatenate([jnp.pad(vb, shift)[:, :-1], vb], axis=2)
    s = jnp.einsum('nbqhd,nbkhd->nbhqk', qb, kk).astype(jnp.float32) * (hd ** -0.5)
    qi = jnp.arange(BLOCK)[:, None]
    kj = jnp.arange(2 * BLOCK)[None, :]
    dist = qi + BLOCK - kj
    key_abs = jnp.arange(nb)[:, None, None] * BLOCK + kj[None] - BLOCK
    valid = (dist >= 0)[None] & (dist <= window_keys)[None] & (key_abs >= 0)
    s = jnp.where(valid[None, :, None], s, -jnp.inf)
    m = jnp.max(s, axis=-1, keepdims=True)
    p = jnp.exp(s - m)
    den = jnp.sum(p, axis=-1, keepdims=True)
    lse = (m + jnp.log(den))[..., 0]
    o = jnp.einsum('nbhqk,nbkhd->nbqhd', (p / den).astype(v.dtype), vv)
    o = o.reshape(N, Lp, H, hd)[:, :L]
    lse = lse.transpose(0, 1, 3, 2).reshape(N, Lp, H)[:, :L]
    return o, lse


def dilated_window_attn(q, k, v, window, dilation):
    B, S, H, hd = q.shape
    L = S // dilation

    def to_res(t):
        return t.reshape(B, L, dilation, H, hd).transpose(0, 2, 1, 3, 4).reshape(B * dilation, L, H, hd)

    o, lse = banded_window_attn(to_res(q), to_res(k), to_res(v), window // dilation)
    o = o.reshape(B, dilation, L, H, hd).transpose(0, 2, 1, 3, 4).reshape(B, S, H, hd)
    lse = lse.reshape(B, dilation, L, H).transpose(0, 2, 1, 3).reshape(B, S, H)
    return o, lse


def causal_depthwise_conv(u, w):
    S = u.shape[1]
    up = jnp.pad(u, ((0, 0), (CONV_K - 1, 0), (0, 0)))
    y = up[:, 0:S] * w[0]
    for j in range(1, CONV_K):
        y = y + up[:, j:j + S] * w[j]
    return y


def setup_inputs(seed: int = 0) -> dict:
    key = jax.random.key(seed)
    ks = jax.random.split(key, 6)
    x = jax.random.normal(ks[0], (BATCH, SEQ, D_MODEL), jnp.float32)
    norm_pre_g = 1.0 + 0.01 * jax.random.normal(ks[1], (D_MODEL,), jnp.float32)
    w_in = jax.random.normal(ks[2], (D_MODEL, IN_WIDTH), jnp.float32) * D_MODEL ** -0.5
    conv_w = jax.random.normal(ks[3], (CONV_K, CONV_WIDTH), jnp.float32) * CONV_K ** -0.5
    w_out = jax.random.normal(ks[4], (MIX_WIDTH, D_MODEL), jnp.float32) * MIX_WIDTH ** -0.5
    norm_post_g = 1.0 + 0.01 * jax.random.normal(ks[5], (D_MODEL,), jnp.float32)
    return {"x": x, "norm_pre_g": norm_pre_g, "w_in": w_in, "conv_w": conv_w,
            "w_out": w_out, "norm_post_g": norm_post_g}


def reference(x, norm_pre_g, w_in, conv_w, w_out, norm_post_g):
    B, S, _ = x.shape
    pos = jnp.arange(S)
    for _layer in range(DEPTH):
        h = rmsnorm(x, norm_pre_g)
        z = jnp.einsum('bsd,de->bse', h, w_in)
        A, C = ATTN_WIDTH, CONV_WIDTH
        cuts = np.cumsum([A, A, A, A, C, C, C])
        q, k, v, g_attn, c_h, c_b, c_c, g_conv = jnp.split(z, cuts, axis=-1)

        q = rope(q.reshape(B, S, N_ATTN_HEADS, HEAD_DIM), pos)
        k = rope(k.reshape(B, S, N_ATTN_HEADS, HEAD_DIM), pos)
        v = v.reshape(B, S, N_ATTN_HEADS, HEAD_DIM)
        outs, lses = [], []
        for window, dilation in DILATED_PATTERNS:
            o_i, lse_i = dilated_window_attn(q, k, v, window, dilation)
            outs.append(o_i)
            lses.append(lse_i)
        mix_w = jax.nn.softmax(jnp.stack(lses, axis=0), axis=0)
        o = jnp.sum(mix_w[..., None] * jnp.stack(outs, axis=0).astype(jnp.float32), axis=0)
        attn_out = o.astype(x.dtype).reshape(B, S, ATTN_WIDTH) * jax.nn.silu(g_attn)

        conv_out = c_b * causal_depthwise_conv(c_c * c_h, conv_w.astype(x.dtype))
        conv_out = conv_out * jax.nn.silu(g_conv)

        mixed = jnp.concatenate([attn_out, conv_out], axis=-1)
        y = jnp.einsum('bse,ed->bsd', mixed, w_out)
        x = x + rmsnorm(y, norm_post_g)
    return x
```

```cpp
#include <hip/hip_runtime.h>
#include <hip/hip_cooperative_groups.h>
#include <cstdio>
#include <cstdint>
#include <cmath>
namespace cg = cooperative_groups;
#define MK_N_LAUNCHES 1
namespace pg8 {
#define PG8_LAS __attribute__((address_space(3)))
typedef unsigned short bf16_t;
typedef short bf16x8 __attribute__((ext_vector_type(8)));
typedef float f32x4 __attribute__((ext_vector_type(4)));
typedef unsigned u32x4 __attribute__((ext_vector_type(4)));
constexpr int BM = 256, BK = 64, HALF = 128, HTB = HALF * BK * 2  , STAGE_BYTES = 8 * HTB, NXCD = 8, WGM = 8;

__host__ __device__ __forceinline__ int lds_byte(int r, int c) { const int st = (r >> 4) * 2 + (c >> 5), rr = r & 15, cc = c & 31, ob = rr * 64 + cc * 2; return st * 1024 + (ob ^ (((ob >> 9) & 1) << 5)); }
__host__ __device__ __forceinline__ void stage_rc(int b, int& R, int& C) { const int st = b / 1024, sb = b % 1024, swz = sb ^ (((sb >> 9) & 1) << 5); R = (st >> 1) * 16 + swz / 64; C = (st & 1) * 32 + (swz % 64) / 2; }
__host__ __device__ __forceinline__ int perm32(int rho) { const int n = rho >> 4, i = rho & 15; return 8 * (i >> 2) + 4 * n + (i & 3); }

struct Unit { int pm, pn; };
struct Gemm { const bf16_t* A; const bf16_t* Bt; int M, N, K; };

struct StaticOrder {
    int nM, nN, nwg, G, c;
    __host__ __device__ void init(int M, int N, int G_, int c_) { nM = M / BM; nN = N / BM; nwg = nM * nN; G = G_; c = c_; }
    __host__ __device__ bool next(int i, Unit& u) const {
        const long L = (long)i * G + c; if (L >= nwg) return false;
        int wgid = (int)L; { const int q = nwg / NXCD, r = nwg % NXCD, xcd = wgid % NXCD, off = wgid / NXCD; wgid = (xcd < r ? xcd * (q + 1) : r * (q + 1) + (xcd - r) * q) + off; }
        const int nig = WGM * nN, gid = wgid / nig, fm = gid * WGM, gsz = (nM - fm) < WGM ? (nM - fm) : WGM;
        u.pm = fm + ((wgid % nig) % gsz); u.pn = (wgid % nig) / gsz; return true;
    }
    __device__ __forceinline__ void a_ready(const Unit&) const {}
    __device__ __forceinline__ void done(const Unit&) const {}
};

__device__ __forceinline__ unsigned cvt_pk_bf16(float lo, float hi) { unsigned r; asm volatile("v_cvt_pk_bf16_f32 %0, %1, %2" : "=v"(r) : "v"(lo), "v"(hi)); return r; }
typedef float f32x2 __attribute__((ext_vector_type(2)));
__device__ __forceinline__ f32x2 gelu_pk(f32x2 v) {
    const f32x2 av = __builtin_elementwise_abs(v), d = av * 0.2316418882f + 1.0f;
    f32x2 t; t.x = __builtin_amdgcn_rcpf(d.x); t.y = __builtin_amdgcn_rcpf(d.y);
    f32x2 q = t * 0.5307027145f + (-0.7265760135f); q = q * t + 0.7107068705f; q = q * t + (-0.142248368f); q = q * t + 0.127414796f; q = q * t;
    const f32x2 s = (v * v) * (-0.72134752044f);
    f32x2 e; e.x = __builtin_amdgcn_exp2f(s.x); e.y = __builtin_amdgcn_exp2f(s.y);
    const f32x2 m = v * (q * e), r = v - m;
    f32x2 o; o.x = v.x < 0.f ? m.x : r.x; o.y = v.y < 0.f ? m.y : r.y; return o;
}

template <int ACT  > struct EpiBf16 {
    static constexpr bool PERM = true, AFTER_DRAIN = false; static_assert(ACT == 0 || ACT == 1, "EpiBf16: ACT is 0 (none) or 1 (gelu_pk)");
    bf16_t* O; int ldc; const float* bias; int split_cols; size_t split_stride; float scale0;
    __device__ __forceinline__ void operator()(const f32x4 (&acc)[2][2][4][2], const Unit& u, int wr, int wc, int fr, int fq) const {
        const int row0 = u.pm * BM + wr * 64 + fr; int colt = u.pn * BM; bf16_t* base = O;
        float sc = 1.f; if (split_cols) { const int t = colt / split_cols; base += (size_t)t * split_stride; colt -= t * split_cols; if (t == 0) sc = scale0; }
        const int col0 = colt + wc * 32 + 8 * fq, bcol0 = u.pn * BM + wc * 32 + 8 * fq;
        f32x4 bv[2][2];
#pragma unroll
        for (int bj = 0; bj < 2; ++bj)
#pragma unroll
            for (int n = 0; n < 2; ++n) bv[bj][n] = bias ? *(const f32x4*)(bias + bcol0 + bj * HALF + 4 * n) : (f32x4){0.f, 0.f, 0.f, 0.f};
#pragma unroll
        for (int ai = 0; ai < 2; ++ai)
#pragma unroll
            for (int m = 0; m < 4; ++m) { bf16_t* rowp = base + (size_t)(row0 + ai * HALF + m * 16) * ldc + col0;
#pragma unroll
                for (int bj = 0; bj < 2; ++bj) { f32x4 v0 = acc[ai][bj][m][0] + bv[bj][0], v1 = acc[ai][bj][m][1] + bv[bj][1];
                    if (ACT == 1) { f32x2 a = gelu_pk((f32x2){v0[0], v0[1]}), b = gelu_pk((f32x2){v0[2], v0[3]}), c = gelu_pk((f32x2){v1[0], v1[1]}), d = gelu_pk((f32x2){v1[2], v1[3]});
                        v0 = (f32x4){a.x, a.y, b.x, b.y}; v1 = (f32x4){c.x, c.y, d.x, d.y}; }
                    v0 = v0 * sc; v1 = v1 * sc; u32x4 w; w.x = cvt_pk_bf16(v0[0], v0[1]); w.y = cvt_pk_bf16(v0[2], v0[3]); w.z = cvt_pk_bf16(v1[0], v1[1]); w.w = cvt_pk_bf16(v1[2], v1[3]);
                    *(u32x4*)(rowp + bj * HALF) = w; } }
    }
};
template <class Epi, class Sched, bool ALIGN_EPI = false, bool SP2 = false>
__device__ __forceinline__ void gemm_phase(PG8_LAS unsigned char* lds, const Gemm g, const Sched& S, const Epi& E) {
    const int tid = threadIdx.x, wid = __builtin_amdgcn_readfirstlane(tid >> 6), lane = tid & 63, wr = wid >> 2, wc = wid & 3, fr = lane & 15, fq = lane >> 4;
    const int K = g.K, nt = K / BK;
    unsigned voffA[2], voffB[2];
#pragma unroll
    for (int i = 0; i < 2; ++i) { int R, C; stage_rc(tid * 16 + i * 8192, R, C); const int Rb = Epi::PERM ? ((R & ~31) + perm32(R & 31)) : R;
        voffA[i] = (unsigned)(R * K + C) * 2u; voffB[i] = (unsigned)(Rb * K + C) * 2u; }
    const size_t kstep = (size_t)(BK * 2);
    const size_t hstep = (size_t)HALF * K * 2;
    const size_t tstep = 2 * hstep;
    const unsigned ldsw = (unsigned)wid * 1024u;
    const int aoff = lds_byte(wr * 64 + fr, fq * 8), boff = lds_byte(wc * 32 + fr, fq * 8);
#define PG8_SA(b, h) (((b) * 2 + (h)) * HTB)
#define PG8_SB(b, h) ((4 + (b) * 2 + (h)) * HTB)
#define PG8_STAGE(bufoff, gbase, voff) do { _Pragma("unroll") for (int _i = 0; _i < 2; ++_i) \
        __builtin_amdgcn_global_load_lds((const unsigned*)((const char*)(gbase) + (voff)[_i]), (PG8_LAS unsigned*)(lds + (bufoff) + ldsw + _i * 8192), 16, 0, 0); } while (0)
#define PG8_LDA(dst, b, h) do { _Pragma("unroll") for (int m = 0; m < 4; ++m) _Pragma("unroll") for (int k = 0; k < 2; ++k) dst[m][k] = *(const PG8_LAS bf16x8*)(lds + PG8_SA(b, h) + aoff + m * 2048 + k * 1024); } while (0)
#define PG8_LDB(dst, b, h) do { _Pragma("unroll") for (int n = 0; n < 2; ++n) _Pragma("unroll") for (int k = 0; k < 2; ++k) dst[n][k] = *(const PG8_LAS bf16x8*)(lds + PG8_SB(b, h) + boff + n * 2048 + k * 1024); } while (0)
#define PG8_MMA(ai, bj, At, Bt) do { __builtin_amdgcn_s_setprio(1); _Pragma("unroll") for (int m = 0; m < 4; ++m) _Pragma("unroll") for (int n = 0; n < 2; ++n) _Pragma("unroll") for (int k = 0; k < 2; ++k) \
        acc[ai][bj][m][n] = __builtin_amdgcn_mfma_f32_16x16x32_bf16(Bt[n][k], At[m][k], acc[ai][bj][m][n], 0, 0, 0); __builtin_amdgcn_s_setprio(0); } while (0)
#define PG8_WAIT_V(n) asm volatile("s_waitcnt vmcnt(" #n ")" ::: "memory")
#define PG8_WAIT_L(n) asm volatile("s_waitcnt lgkmcnt(" #n ")" ::: "memory")
#define PG8_BAR __builtin_amdgcn_s_barrier()
#define PG8_SCHED __builtin_amdgcn_sched_barrier(0)
    Unit cur, nxt; int ui = 0;
    if (!S.next(0, cur)) return;
    f32x4 acc[2][2][4][2];
#pragma unroll
    for (int a = 0; a < 2; ++a)
#pragma unroll
        for (int b = 0; b < 2; ++b)
#pragma unroll
            for (int m = 0; m < 4; ++m)
#pragma unroll
                for (int n = 0; n < 2; ++n) acc[a][b][m][n] = (f32x4){0.f, 0.f, 0.f, 0.f};
    bf16x8 At[4][2], B0[2][2], B1[2][2];
    const char* cA = (const char*)g.A + (size_t)cur.pm * tstep; const char* cB = (const char*)g.Bt + (size_t)cur.pn * tstep;
    S.a_ready(cur);
    if constexpr (SP2) {
        PG8_STAGE(PG8_SB(0, 0), cB, voffB); PG8_STAGE(PG8_SB(0, 1), cB + hstep, voffB); PG8_STAGE(PG8_SA(0, 0), cA, voffA); PG8_STAGE(PG8_SA(0, 1), cA + hstep, voffA);
        if (wr == 1) PG8_BAR;
        PG8_WAIT_V(2); PG8_BAR;
        PG8_STAGE(PG8_SB(1, 0), cB + kstep, voffB); PG8_STAGE(PG8_SA(1, 0), cA + kstep, voffA); PG8_STAGE(PG8_SB(1, 1), cB + hstep + kstep, voffB);
        PG8_WAIT_V(6); PG8_BAR;
    } else {
        PG8_STAGE(PG8_SB(0, 0), cB, voffB); PG8_STAGE(PG8_SA(0, 0), cA, voffA); PG8_STAGE(PG8_SB(0, 1), cB + hstep, voffB); PG8_STAGE(PG8_SA(0, 1), cA + hstep, voffA);
        if (wr == 1) PG8_BAR;
        PG8_WAIT_V(4); PG8_BAR;
        PG8_STAGE(PG8_SB(1, 0), cB + kstep, voffB); PG8_STAGE(PG8_SA(1, 0), cA + kstep, voffA); PG8_STAGE(PG8_SB(1, 1), cB + hstep + kstep, voffB);
        PG8_WAIT_V(6); PG8_BAR;
    }
    for (;;) {
        const bool has_next = S.next(ui + 1, nxt);
        const char* nA = has_next ? (const char*)g.A + (size_t)nxt.pm * tstep : cA; const char* nB = has_next ? (const char*)g.Bt + (size_t)nxt.pn * tstep : cB;
        for (int t = 0; t < nt; t += 2) {
            const bool last = (t == nt - 2);
            const char* a1 = cA + (size_t)(t + 1) * kstep;
            const char* a2 = last ? nA : cA + (size_t)(t + 2) * kstep; const char* b2 = last ? nB : cB + (size_t)(t + 2) * kstep;
            const char* a3 = a2 + kstep; const char* b3 = b2 + kstep;
            if (last && has_next) S.a_ready(nxt);
            if constexpr (SP2) {
            PG8_LDB(B0, 0, 0); PG8_LDB(B1, 0, 1); PG8_SCHED; PG8_LDA(At, 0, 0); PG8_STAGE(PG8_SA(1, 1), a1 + hstep, voffA);
            PG8_WAIT_V(8); PG8_WAIT_L(0); PG8_BAR; PG8_MMA(0, 0, At, B0); PG8_MMA(0, 1, At, B1); PG8_BAR; PG8_SCHED;
            PG8_LDA(At, 0, 1); PG8_STAGE(PG8_SB(0, 0), b2, voffB); PG8_STAGE(PG8_SB(0, 1), b2 + hstep, voffB); PG8_STAGE(PG8_SA(0, 0), a2, voffA);
            PG8_WAIT_V(8); PG8_WAIT_L(0); PG8_BAR; PG8_MMA(1, 0, At, B0); PG8_MMA(1, 1, At, B1); PG8_BAR; PG8_SCHED;
            PG8_LDB(B0, 1, 0); PG8_LDB(B1, 1, 1); PG8_SCHED; PG8_LDA(At, 1, 0); PG8_STAGE(PG8_SA(0, 1), a2 + hstep, voffA);
            PG8_WAIT_V(8); PG8_WAIT_L(0); PG8_BAR; PG8_MMA(0, 0, At, B0); PG8_MMA(0, 1, At, B1); PG8_BAR; PG8_SCHED;
            PG8_LDA(At, 1, 1); PG8_STAGE(PG8_SB(1, 0), b3, voffB); PG8_STAGE(PG8_SB(1, 1), b3 + hstep, voffB); PG8_STAGE(PG8_SA(1, 0), a3, voffA);
            PG8_WAIT_V(8); PG8_WAIT_L(0); PG8_BAR; PG8_MMA(1, 0, At, B0); PG8_MMA(1, 1, At, B1); PG8_BAR; PG8_SCHED;
            } else {
            PG8_LDB(B0, 0, 0); PG8_SCHED; PG8_LDA(At, 0, 0); PG8_STAGE(PG8_SA(1, 1), a1 + hstep, voffA);
            PG8_WAIT_L(8); PG8_BAR; PG8_WAIT_L(0); PG8_MMA(0, 0, At, B0); PG8_BAR; PG8_SCHED;
            PG8_LDB(B1, 0, 1); PG8_STAGE(PG8_SB(0, 0), b2, voffB);
            PG8_BAR; PG8_WAIT_L(0); PG8_MMA(0, 1, At, B1); PG8_BAR;
            PG8_LDA(At, 0, 1); PG8_STAGE(PG8_SA(0, 0), a2, voffA);
            PG8_BAR; PG8_WAIT_L(0); PG8_MMA(1, 0, At, B0); PG8_BAR; PG8_SCHED;
            PG8_STAGE(PG8_SB(0, 1), b2 + hstep, voffB);
            PG8_WAIT_V(6); PG8_BAR; PG8_MMA(1, 1, At, B1); PG8_BAR;
            PG8_LDB(B0, 1, 0); PG8_SCHED; PG8_LDA(At, 1, 0); PG8_STAGE(PG8_SA(0, 1), a2 + hstep, voffA);
            PG8_WAIT_L(8); PG8_BAR; PG8_WAIT_L(0); PG8_MMA(0, 0, At, B0); PG8_BAR; PG8_SCHED;
            PG8_LDB(B1, 1, 1); PG8_STAGE(PG8_SB(1, 0), b3, voffB);
            PG8_BAR; PG8_WAIT_L(0); PG8_MMA(0, 1, At, B1); PG8_BAR;
            PG8_LDA(At, 1, 1); PG8_STAGE(PG8_SA(1, 0), a3, voffA);
            PG8_BAR; PG8_WAIT_L(0); PG8_MMA(1, 0, At, B0); PG8_BAR; PG8_SCHED;
            PG8_STAGE(PG8_SB(1, 1), b3 + hstep, voffB);
            PG8_WAIT_V(6); PG8_BAR; PG8_MMA(1, 1, At, B1); PG8_BAR;
            }
        }
        if constexpr (ALIGN_EPI) { if (wr == 0) PG8_BAR; }
        if constexpr (!Epi::AFTER_DRAIN) { E(acc, cur, wr, wc, fr, fq); S.done(cur); }
        if (!has_next) break;
#pragma unroll
        for (int a = 0; a < 2; ++a)
#pragma unroll
            for (int b = 0; b < 2; ++b)
#pragma unroll
                for (int m = 0; m < 4; ++m)
#pragma unroll
                    for (int n = 0; n < 2; ++n) acc[a][b][m][n] = (f32x4){0.f, 0.f, 0.f, 0.f};
        cur = nxt; cA = nA; cB = nB; ++ui;
        if constexpr (ALIGN_EPI) { if (wr == 1) PG8_BAR; }
    }
    PG8_WAIT_V(0);
    if constexpr (!ALIGN_EPI) { if (wr == 0) PG8_BAR; }
    PG8_BAR;
    if constexpr (Epi::AFTER_DRAIN) { E.fused(acc, cur, wr, wc, fr, fq, lds, wid, lane); S.done(cur); }
#undef PG8_SA
#undef PG8_SB
#undef PG8_STAGE
#undef PG8_LDA
#undef PG8_LDB
#undef PG8_MMA
#undef PG8_WAIT_V
#undef PG8_WAIT_L
#undef PG8_BAR
#undef PG8_SCHED
}
}

#ifndef MK_N_LAUNCHES
#define MK_N_LAUNCHES 1
#endif
constexpr int NPHASE = 6;
constexpr int BATCH = 4, SEQ = 8192, DM = 1024, M = BATCH * SEQ;
constexpr int AW = 768, NH = 12, HD = 64, CW = 256, INW = 4096;
constexpr float NORM_EPS = 1e-6f;
constexpr float QSCALE = 0.125f * 1.4426950408889634f;

#define LAS __attribute__((address_space(3)))
typedef unsigned short bf16_t;
typedef short bf16x8 __attribute__((ext_vector_type(8)));
typedef short s16x4 __attribute__((ext_vector_type(4)));
typedef float f32x4 __attribute__((ext_vector_type(4)));
typedef float f32x16 __attribute__((ext_vector_type(16)));
typedef unsigned u32x4 __attribute__((ext_vector_type(4)));
typedef unsigned u32x2 __attribute__((ext_vector_type(2)));

constexpr size_t MiB = 1u << 20;
constexpr size_t WS_WIN = 1 * MiB, WS_WOUT = 9 * MiB, WS_ROPEC = 11 * MiB, WS_ROPES = 12 * MiB;
constexpr size_t WS_XN = 16 * MiB;
constexpr size_t WS_Q = 80 * MiB, WS_K = 128 * MiB, WS_V = 176 * MiB, WS_G = 224 * MiB;
constexpr size_t WS_U = 272 * MiB, WS_GB = 288 * MiB;
constexpr size_t WS_O = 304 * MiB;
constexpr size_t WS_LSE = 448 * MiB;
constexpr size_t WS_Y = 80 * MiB;
constexpr size_t WS_END = 456 * MiB;
constexpr size_t O_STRIDE = (size_t)M * AW, LSE_STRIDE = (size_t)M * NH;

constexpr int LDS_BYTES = 147456;

__device__ __forceinline__ float bf2f(unsigned short b) { return __uint_as_float((unsigned)b << 16); }
__device__ __forceinline__ float bflo(unsigned w) { return __uint_as_float(w << 16); }
__device__ __forceinline__ float bfhi(unsigned w) { return __uint_as_float(w & 0xffff0000u); }
__device__ __forceinline__ unsigned pk2(float lo, float hi) { return pg8::cvt_pk_bf16(lo, hi); }
__device__ __forceinline__ float silu_f(float v) { return v * __builtin_amdgcn_rcpf(1.0f + __builtin_amdgcn_exp2f(-1.4426950408889634f * v)); }
__device__ __forceinline__ float wave_sum(float v) {
#pragma unroll
    for (int o = 1; o < 64; o <<= 1) v += __shfl_xor(v, o);
    return v;
}

__host__ __device__ __forceinline__ int src_col(int j) {
    const int pn = j >> 8, jj = j & 255, bj = jj >> 7, wc = (jj >> 5) & 3;
    if (pn < 12) { const int type = pn / 3, tt = pn % 3; return type * AW + (4 * tt + wc) * 64 + 32 * bj + (jj & 31); }
    const int ct = pn - 12, fq = (jj >> 3) & 3, n = (jj >> 2) & 1, i = jj & 3;
    const int arr = (bj == 0) ? (n == 0 ? 0 : 512) : (n == 0 ? 256 : 768);
    return 4 * AW + arr + 64 * ct + 16 * wc + 4 * fq + i;
}

struct EpiIn {
    static constexpr bool PERM = true, AFTER_DRAIN = false;
    bf16_t *Q, *K, *V, *G, *U, *GB; const float* ropec; const float* ropes;
    __device__ __forceinline__ void operator()(const f32x4 (&acc)[2][2][4][2], const pg8::Unit& u, int wr, int wc, int fr, int fq) const {
        const int pn = u.pn, row0 = u.pm * 256 + wr * 64 + fr;
        if (pn < 12) {
            const int type = pn / 3, tt = pn - 3 * type;
            bf16_t* base = (type == 0) ? Q : (type == 1) ? K : (type == 2) ? V : G;
            const int col = (4 * tt + wc) * 64 + 8 * fq;
#pragma unroll
            for (int ai = 0; ai < 2; ++ai)
#pragma unroll
                for (int m = 0; m < 4; ++m) {
                    const int row = row0 + ai * 128 + m * 16;
                    f32x4 a0 = acc[ai][0][m][0], a1 = acc[ai][0][m][1], b0 = acc[ai][1][m][0], b1 = acc[ai][1][m][1];
                    if (type < 2) {
                        const int pos = row & (SEQ - 1);
                        const f32x4 c0 = *(const f32x4*)(ropec + pos * 32 + 8 * fq), c1 = *(const f32x4*)(ropec + pos * 32 + 8 * fq + 4);
                        const f32x4 s0 = *(const f32x4*)(ropes + pos * 32 + 8 * fq), s1 = *(const f32x4*)(ropes + pos * 32 + 8 * fq + 4);
                        const f32x4 x0 = a0 * c0 - b0 * s0, x1 = a1 * c1 - b1 * s1, y0 = b0 * c0 + a0 * s0, y1 = b1 * c1 + a1 * s1;
                        const float sc = (type == 0) ? QSCALE : 1.0f;
                        a0 = x0 * sc; a1 = x1 * sc; b0 = y0 * sc; b1 = y1 * sc;
                    } else if (type == 3) {
#pragma unroll
                        for (int i = 0; i < 4; ++i) { a0[i] = silu_f(a0[i]); a1[i] = silu_f(a1[i]); b0[i] = silu_f(b0[i]); b1[i] = silu_f(b1[i]); }
                    }
                    bf16_t* rp = base + (size_t)row * AW + col;
                    u32x4 w; w.x = pk2(a0[0], a0[1]); w.y = pk2(a0[2], a0[3]); w.z = pk2(a1[0], a1[1]); w.w = pk2(a1[2], a1[3]);
                    *(u32x4*)rp = w;
                    w.x = pk2(b0[0], b0[1]); w.y = pk2(b0[2], b0[3]); w.z = pk2(b1[0], b1[1]); w.w = pk2(b1[2], b1[3]);
                    *(u32x4*)(rp + 32) = w;
                }
        } else {
            const int ch = 64 * (pn - 12) + 16 * wc + 4 * fq;
#pragma unroll
            for (int ai = 0; ai < 2; ++ai)
#pragma unroll
                for (int m = 0; m < 4; ++m) {
                    const int row = row0 + ai * 128 + m * 16;
                    const f32x4 vh = acc[ai][0][m][0], vc = acc[ai][0][m][1], vb = acc[ai][1][m][0], vg = acc[ai][1][m][1];
                    const f32x4 uu = vc * vh;
                    f32x4 gb;
#pragma unroll
                    for (int i = 0; i < 4; ++i) gb[i] = vb[i] * silu_f(vg[i]);
                    u32x2 w; w.x = pk2(uu[0], uu[1]); w.y = pk2(uu[2], uu[3]);
                    *(u32x2*)(U + (size_t)row * CW + ch) = w;
                    w.x = pk2(gb[0], gb[1]); w.y = pk2(gb[2], gb[3]);
                    *(u32x2*)(GB + (size_t)row * CW + ch) = w;
                }
        }
    }
};

struct EpiY {
    static constexpr bool PERM = true, AFTER_DRAIN = false;
    bf16_t* O; int ldc;
    __device__ __forceinline__ void operator()(const f32x4 (&acc)[2][2][4][2], const pg8::Unit& u, int wr, int wc, int fr, int fq) const {
        const int row0 = u.pm * 256 + wr * 64 + fr, col0 = u.pn * 256 + wc * 32 + 8 * fq;
#pragma unroll
        for (int ai = 0; ai < 2; ++ai)
#pragma unroll
            for (int m = 0; m < 4; ++m) { bf16_t* rowp = O + (size_t)(row0 + ai * 128 + m * 16) * ldc + col0;
#pragma unroll
                for (int bj = 0; bj < 2; ++bj) { const f32x4 v0 = acc[ai][bj][m][0], v1 = acc[ai][bj][m][1];
                    u32x4 w; w.x = pk2(v0[0], v0[1]); w.y = pk2(v0[2], v0[3]); w.z = pk2(v1[0], v1[1]); w.w = pk2(v1[2], v1[3]);
                    *(u32x4*)(rowp + bj * 128) = w; } }
    }
};

namespace att {
constexpr int NK = 384, KCH = NK * 16, VH = NK * 64;
constexpr int LDS_K = 0, LDS_V = 8 * KCH, LDS_TOTAL = LDS_V + 2 * VH;
__device__ __forceinline__ int crow(int r, int hi) { return (r & 3) + 8 * (r >> 2) + 4 * hi; }
typedef short v4i16_t __attribute__((ext_vector_type(4)));
__device__ __forceinline__ s16x4 vtr(const LAS unsigned char* p) { return __builtin_bit_cast(s16x4, __builtin_amdgcn_ds_read_tr16_b64_v4i16((LAS v4i16_t*)p)); }

__device__ __forceinline__ void attn_unit(LAS unsigned char* lds, const bf16_t* Q, const bf16_t* K, const bf16_t* V, bf16_t* O, float* LSE, int dil, int b, int h, int res, int qb) {
    const int tid = threadIdx.x, lane = tid & 63, r32 = lane & 31, hi = lane >> 5;
    const int w = __builtin_amdgcn_readfirstlane(tid >> 6);
    const int m0 = qb * 256;
    const size_t rowb = (size_t)b * SEQ;
#pragma unroll
    for (int i = 0; i < 6; ++i) {
        int pos = m0 - 128 + 64 * i + lane; pos = pos < 0 ? 0 : pos;
        const bf16_t* src = K + (rowb + (size_t)pos * dil + res) * AW + h * HD + 8 * w;
        __builtin_amdgcn_global_load_lds((const unsigned*)src, (LAS unsigned*)(lds + LDS_K + w * KCH + 64 * i * 16), 16, 0, 0);
    }
#pragma unroll
    for (int i = 0; i < 6; ++i) {
        int pos = m0 - 128 + 64 * i + 16 * (w & 3) + (lane >> 2); pos = pos < 0 ? 0 : pos;
        const bf16_t* src = V + (rowb + (size_t)pos * dil + res) * AW + h * HD + (w >> 2) * 32 + (lane & 3) * 8;
        __builtin_amdgcn_global_load_lds((const unsigned*)src, (LAS unsigned*)(lds + LDS_V + (w >> 2) * VH + (64 * i + 16 * (w & 3)) * 64), 16, 0, 0);
    }
    const size_t qrow = rowb + (size_t)(m0 + 32 * w + r32) * dil + res;
    bf16x8 qf[4];
#pragma unroll
    for (int d0 = 0; d0 < 4; ++d0) qf[d0] = *(const bf16x8*)(Q + qrow * AW + h * HD + 16 * d0 + 8 * hi);
    asm volatile("s_waitcnt vmcnt(0)" ::: "memory");
    __syncthreads();
    f32x16 s[5];
#pragma unroll
    for (int j = 0; j < 5; ++j) {
        f32x16 a = {};
#pragma unroll
        for (int d0 = 0; d0 < 4; ++d0) {
            const bf16x8 kf = *(const LAS bf16x8*)(lds + LDS_K + (2 * d0 + hi) * KCH + (32 * (w + j) + r32) * 16);
            a = __builtin_amdgcn_mfma_f32_32x32x16_bf16(kf, qf[d0], a, 0, 0, 0);
        }
        s[j] = a;
    }
    const bool firstblk = (m0 == 0);
    float mx = -INFINITY;
#pragma unroll
    for (int j = 0; j < 5; ++j) {
        const bool dead = firstblk && (w + j) < 4;
#pragma unroll
        for (int r = 0; r < 16; ++r) {
            const int kk = crow(r, hi);
            bool ok = !dead;
            if (j == 0) ok = ok && (kk >= r32);
            if (j == 4) ok = ok && (kk <= r32);
            const float v = ok ? s[j][r] : -INFINITY;
            s[j][r] = v; mx = fmaxf(mx, v);
        }
    }
    mx = fmaxf(mx, __shfl_xor(mx, 32));
    float l = 0.f;
#pragma unroll
    for (int j = 0; j < 5; ++j)
#pragma unroll
        for (int r = 0; r < 16; ++r) { const float p = __builtin_amdgcn_exp2f(s[j][r] - mx); s[j][r] = p; l += p; }
    l += __shfl_xor(l, 32);
    f32x16 o[2]; o[0] = f32x16{}; o[1] = f32x16{};
    const int cgp = (lane >> 4) & 1, q4 = (lane & 15) >> 2, p4 = lane & 3;
    const LAS unsigned char* vbase = lds + LDS_V + (4 * hi + q4) * 64 + (16 * cgp + 4 * p4) * 2;
#pragma unroll
    for (int j = 0; j < 5; ++j)
#pragma unroll
        for (int s2 = 0; s2 < 2; ++s2) {
            u32x4 pw; pw.x = pk2(s[j][8 * s2 + 0], s[j][8 * s2 + 1]); pw.y = pk2(s[j][8 * s2 + 2], s[j][8 * s2 + 3]);
            pw.z = pk2(s[j][8 * s2 + 4], s[j][8 * s2 + 5]); pw.w = pk2(s[j][8 * s2 + 6], s[j][8 * s2 + 7]);
            const bf16x8 pf = __builtin_bit_cast(bf16x8, pw);
#pragma unroll
            for (int dh = 0; dh < 2; ++dh) {
                const LAS unsigned char* vp = vbase + dh * VH + (32 * (w + j) + 16 * s2) * 64;
                const s16x4 lo = vtr(vp), hh = vtr(vp + 8 * 64);
                const bf16x8 vf = (bf16x8){lo[0], lo[1], lo[2], lo[3], hh[0], hh[1], hh[2], hh[3]};
                o[dh] = __builtin_amdgcn_mfma_f32_32x32x16_bf16(vf, pf, o[dh], 0, 0, 0);
            }
        }
    const float inv = 1.0f / l;
    bf16_t* op = O + qrow * AW + h * HD;
#pragma unroll
    for (int dh = 0; dh < 2; ++dh)
#pragma unroll
        for (int g = 0; g < 4; ++g) {
            u32x2 wv; wv.x = pk2(o[dh][4 * g] * inv, o[dh][4 * g + 1] * inv); wv.y = pk2(o[dh][4 * g + 2] * inv, o[dh][4 * g + 3] * inv);
            *(u32x2*)(op + 32 * dh + 8 * g + 4 * hi) = wv;
        }
    if (hi == 0) LSE[qrow * NH + h] = mx + __builtin_amdgcn_logf(l);
    __syncthreads();
}
}

struct Args { const float* x; const float* g_pre; const float* w_in; const float* conv_w; const float* w_out; const float* g_post; float* out; unsigned char* ws; float inv_freq[32]; int ph_lo, ph_hi; };

__device__ __forceinline__ void transpose_item(const float* W, int N, bf16_t* WT, int K, int nblk, bool perm, LAS float* scr, int item, int lane) {
    const int kb = item / nblk, nb = item % nblk, k0 = 64 * kb, n0 = 32 * nb;
    const int sc = perm ? src_col(n0 + (lane & 31)) : n0 + (lane & 31);
#pragma unroll 8
    for (int i = 0; i < 32; ++i) { const int kk = 2 * i + (lane >> 5); scr[kk * 33 + (lane & 31)] = W[(size_t)(k0 + kk) * N + sc]; }
    asm volatile("s_waitcnt lgkmcnt(0)" ::: "memory");
    const int c = lane & 7;
#pragma unroll
    for (int j = 0; j < 4; ++j) { const int n = (lane >> 3) + 8 * j; const LAS float* s = scr + (8 * c) * 33 + n;
        u32x4 o; o.x = pk2(s[0 * 33], s[1 * 33]); o.y = pk2(s[2 * 33], s[3 * 33]); o.z = pk2(s[4 * 33], s[5 * 33]); o.w = pk2(s[6 * 33], s[7 * 33]);
        *(u32x4*)(WT + (size_t)(n0 + n) * K + k0 + 8 * c) = o; }
    asm volatile("s_waitcnt lgkmcnt(0)" ::: "memory");
}

__global__ void __launch_bounds__(512, 2) hybrid_fwd(Args args) {
    extern __shared__ __attribute__((aligned(16))) unsigned char lds_raw[];
    LAS unsigned char* lds = (LAS unsigned char*)lds_raw;
    const int tid = threadIdx.x, lane = tid & 63, wave = __builtin_amdgcn_readfirstlane(tid >> 6);
    const int G = gridDim.x, bx = blockIdx.x;
    unsigned char* ws = args.ws;
    bf16_t* Win_t = (bf16_t*)(ws + WS_WIN); bf16_t* Wout_t = (bf16_t*)(ws + WS_WOUT);
    float* ropec = (float*)(ws + WS_ROPEC); float* ropes = (float*)(ws + WS_ROPES);
    bf16_t* XN = (bf16_t*)(ws + WS_XN); bf16_t* MIX = (bf16_t*)(ws + WS_XN);
    bf16_t* Qb = (bf16_t*)(ws + WS_Q); bf16_t* Kb = (bf16_t*)(ws + WS_K); bf16_t* Vb = (bf16_t*)(ws + WS_V); bf16_t* Gb = (bf16_t*)(ws + WS_G);
    bf16_t* Ub = (bf16_t*)(ws + WS_U); bf16_t* GBb = (bf16_t*)(ws + WS_GB);
    bf16_t* Ob = (bf16_t*)(ws + WS_O); float* LSEb = (float*)(ws + WS_LSE); bf16_t* Yb = (bf16_t*)(ws + WS_Y);
    const int lo = args.ph_lo, hi_ph = args.ph_hi;
#define IN(k) (lo <= (k) && (k) < hi_ph)
#define SEAM(k) do { if (IN(k) && IN((k) + 1)) cg::this_grid().sync(); } while (0)

    if (IN(0)) {
        LAS float* scr = (LAS float*)(lds + wave * 16384);
        const int gw = bx * 8 + wave, NGW = G * 8;
        constexpr int I_IN = (DM / 64) * (INW / 32), I_OUT = (DM / 64) * (DM / 32);
        for (int it = gw; it < I_IN + I_OUT; it += NGW) {
            if (it < I_IN) transpose_item(args.w_in, INW, Win_t, DM, INW / 32, true, scr, it, lane);
            else transpose_item(args.w_out, DM, Wout_t, DM, DM / 32, false, scr, it - I_IN, lane);
        }
        for (int e = bx * 512 + tid; e < SEQ * 32; e += G * 512) {
            const int pos = e >> 5, dd = e & 31;
            const float angf = (float)pos * args.inv_freq[dd];
            const double xa = (double)angf;
            const double nq = rint(xa * 0.63661977236758134308);
            const double r = (xa - nq * 1.57079632679489655800) - nq * 6.123233995736766e-17;
            const double z = r * r;
            const double sn = r * (1.0 - z / 6.0 * (1.0 - z / 20.0 * (1.0 - z / 42.0 * (1.0 - z / 72.0 * (1.0 - z / 110.0 * (1.0 - z / 156.0))))));
            const double cs = 1.0 - z / 2.0 * (1.0 - z / 12.0 * (1.0 - z / 30.0 * (1.0 - z / 56.0 * (1.0 - z / 90.0 * (1.0 - z / 132.0 * (1.0 - z / 182.0))))));
            const int qd = ((int)nq) & 3;
            const double sv = (qd == 0) ? sn : (qd == 1) ? cs : (qd == 2) ? -sn : -cs;
            const double cv = (qd == 0) ? cs : (qd == 1) ? -sn : (qd == 2) ? -cs : sn;
            ropec[e] = (float)cv; ropes[e] = (float)sv;
        }
        for (int m = gw; m < M; m += NGW) {
            const f32x4* xr = (const f32x4*)(args.x + (size_t)m * DM) + lane;
            f32x4 v[4]; float ss = 0.f;
#pragma unroll
            for (int j = 0; j < 4; ++j) { v[j] = xr[64 * j]; ss += (v[j].x * v[j].x + v[j].y * v[j].y) + (v[j].z * v[j].z + v[j].w * v[j].w); }
            const float rstd = 1.0f / sqrtf(wave_sum(ss) * (1.0f / DM) + NORM_EPS);
            unsigned long long* o8 = (unsigned long long*)(XN + (size_t)m * DM) + lane;
#pragma unroll
            for (int j = 0; j < 4; ++j) { const f32x4 g = ((const f32x4*)args.g_pre)[lane + 64 * j];
                o8[64 * j] = (unsigned long long)pk2(v[j].x * rstd * g.x, v[j].y * rstd * g.y) | ((unsigned long long)pk2(v[j].z * rstd * g.z, v[j].w * rstd * g.w) << 32); }
        }
        __syncthreads();
    }
    SEAM(0);

    if (IN(1)) {
        pg8::Gemm g{XN, Win_t, M, INW, DM}; pg8::StaticOrder S; S.init(M, INW, G, bx);
        EpiIn E{Qb, Kb, Vb, Gb, Ub, GBb, ropec, ropes};
        pg8::gemm_phase<EpiIn, pg8::StaticOrder, true, true>(lds, g, S, E);
    }
    SEAM(1);

    if (IN(2)) {
        constexpr int NUNIT = 3 * BATCH * NH * 32;
        for (int u = bx; u < NUNIT; u += G) {
            const int p = u / (BATCH * NH * 32), rem = u % (BATCH * NH * 32), bh = rem >> 5, idx = rem & 31;
            const int b = bh / NH, h = bh % NH;
            const int dil = (p == 0) ? 1 : (p == 1) ? 4 : 16;
            const int nqb = 32 / dil;
            const int res = idx / nqb, qb = idx % nqb;
            att::attn_unit(lds, Qb, Kb, Vb, Ob + (size_t)p * O_STRIDE, LSEb + (size_t)p * LSE_STRIDE, dil, b, h, res, qb);
        }
    }
    SEAM(2);

    if (IN(3)) {
        const int c8 = tid & 127;
        for (int row = bx * 4 + (tid >> 7); row < M; row += G * 4) {
            if (c8 < 96) {
                const int h = c8 >> 3, col = c8 * 8;
                const float l0 = LSEb[(size_t)row * NH + h], l1 = LSEb[LSE_STRIDE + (size_t)row * NH + h], l2 = LSEb[2 * LSE_STRIDE + (size_t)row * NH + h];
                const float mx = fmaxf(l0, fmaxf(l1, l2));
                float w0 = __builtin_amdgcn_exp2f(l0 - mx), w1 = __builtin_amdgcn_exp2f(l1 - mx), w2 = __builtin_amdgcn_exp2f(l2 - mx);
                const float inv = 1.0f / (w0 + w1 + w2); w0 *= inv; w1 *= inv; w2 *= inv;
                const size_t off = (size_t)row * AW + col;
                const u32x4 a = *(const u32x4*)(Ob + off), bq = *(const u32x4*)(Ob + O_STRIDE + off), c = *(const u32x4*)(Ob + 2 * O_STRIDE + off), g = *(const u32x4*)(Gb + off);
                u32x4 o;
#pragma unroll
                for (int i = 0; i < 4; ++i) {
                    const float lo_ = (w0 * bflo(a[i]) + w1 * bflo(bq[i]) + w2 * bflo(c[i])) * bflo(g[i]);
                    const float hi_ = (w0 * bfhi(a[i]) + w1 * bfhi(bq[i]) + w2 * bfhi(c[i])) * bfhi(g[i]);
                    o[i] = pk2(lo_, hi_);
                }
                *(u32x4*)(MIX + (size_t)row * DM + col) = o;
            } else {
                const int ch = (c8 - 96) * 8, pos = row & (SEQ - 1);
                const u32x4 z = {0u, 0u, 0u, 0u};
                const u32x4 u0 = *(const u32x4*)(Ub + (size_t)row * CW + ch);
                const u32x4 u1 = (pos >= 1) ? *(const u32x4*)(Ub + (size_t)(row - 1) * CW + ch) : z;
                const u32x4 u2 = (pos >= 2) ? *(const u32x4*)(Ub + (size_t)(row - 2) * CW + ch) : z;
                const u32x4 gb = *(const u32x4*)(GBb + (size_t)row * CW + ch);
                const float* cw = args.conv_w + ch;
                u32x4 o;
#pragma unroll
                for (int i = 0; i < 4; ++i) {
                    const float lo_ = bflo(gb[i]) * (cw[2 * i] * bflo(u2[i]) + cw[CW + 2 * i] * bflo(u1[i]) + cw[2 * CW + 2 * i] * bflo(u0[i]));
                    const float hi_ = bfhi(gb[i]) * (cw[2 * i + 1] * bfhi(u2[i]) + cw[CW + 2 * i + 1] * bfhi(u1[i]) + cw[2 * CW + 2 * i + 1] * bfhi(u0[i]));
                    o[i] = pk2(lo_, hi_);
                }
                *(u32x4*)(MIX + (size_t)row * DM + AW + ch) = o;
            }
        }
    }
    SEAM(3);

    if (IN(4)) {
        pg8::Gemm g{MIX, Wout_t, M, DM, DM}; pg8::StaticOrder S; S.init(M, DM, G, bx);
        EpiY E{Yb, DM};
        pg8::gemm_phase<EpiY, pg8::StaticOrder, true, true>(lds, g, S, E);
    }
    SEAM(4);

    if (IN(5)) {
        const int gw = bx * 8 + wave, NGW = G * 8;
        for (int m = gw; m < M; m += NGW) {
            const u32x4* yr = (const u32x4*)(Yb + (size_t)m * DM) + lane;
            const u32x4 y0 = yr[0], y1 = yr[64];
            float ss = 0.f;
#pragma unroll
            for (int i = 0; i < 4; ++i) { const float a = bflo(y0[i]), b_ = bfhi(y0[i]), c = bflo(y1[i]), d = bfhi(y1[i]); ss += (a * a + b_ * b_) + (c * c + d * d); }
            const float rstd = 1.0f / sqrtf(wave_sum(ss) * (1.0f / DM) + NORM_EPS);
#pragma unroll
            for (int j = 0; j < 2; ++j) {
                const u32x4 y = j ? y1 : y0;
                const int col = 8 * lane + 512 * j;
                const f32x4* xp = (const f32x4*)(args.x + (size_t)m * DM + col);
                const f32x4* gp = (const f32x4*)(args.g_post + col);
                f32x4* outp = (f32x4*)(args.out + (size_t)m * DM + col);
                const f32x4 xa = xp[0], xb = xp[1], ga = gp[0], gb = gp[1];
                f32x4 oa, ob;
                oa.x = xa.x + bflo(y[0]) * rstd * ga.x; oa.y = xa.y + bfhi(y[0]) * rstd * ga.y; oa.z = xa.z + bflo(y[1]) * rstd * ga.z; oa.w = xa.w + bfhi(y[1]) * rstd * ga.w;
                ob.x = xb.x + bflo(y[2]) * rstd * gb.x; ob.y = xb.y + bfhi(y[2]) * rstd * gb.y; ob.z = xb.z + bflo(y[3]) * rstd * gb.z; ob.w = xb.w + bfhi(y[3]) * rstd * gb.w;
                outp[0] = oa; outp[1] = ob;
            }
        }
    }
#undef IN
#undef SEAM
}

extern "C" void kernel_launch(void* const* d_in, const int* in_sizes, int n_in, void* d_out, int out_size, void* d_ws, size_t ws_size, hipStream_t stream) {
    static int grid = 0;
    if (grid == 0) {
        if (n_in != 6 || in_sizes[0] != M * DM || out_size != M * DM || ws_size < WS_END) { fprintf(stderr, "kernel_launch: unexpected shapes (n_in %d, in0 %d, out %d, ws %zu); nothing launched\n", n_in, n_in > 0 ? in_sizes[0] : -1, out_size, ws_size); grid = -1; return; }
        int dev = 0, cus = 0, per_cu = 0;
        if (hipGetDevice(&dev) != hipSuccess || hipDeviceGetAttribute(&cus, hipDeviceAttributeMultiprocessorCount, dev) != hipSuccess) { grid = -1; return; }
        if (hipFuncSetAttribute((const void*)hybrid_fwd, hipFuncAttributeMaxDynamicSharedMemorySize, LDS_BYTES) != hipSuccess) { fprintf(stderr, "kernel_launch: hipFuncSetAttribute failed\n"); grid = -1; return; }
        if (hipOccupancyMaxActiveBlocksPerMultiprocessor(&per_cu, (const void*)hybrid_fwd, 512, LDS_BYTES) != hipSuccess || per_cu < 1) { fprintf(stderr, "kernel_launch: occupancy query reports %d blocks per CU\n", per_cu); per_cu = 1; }
        (void)hipGetLastError();
        grid = cus;
    }
    if (grid < 0) return;
    Args a{};
    a.x = (const float*)d_in[0]; a.g_pre = (const float*)d_in[1]; a.w_in = (const float*)d_in[2]; a.conv_w = (const float*)d_in[3];
    a.w_out = (const float*)d_in[4]; a.g_post = (const float*)d_in[5]; a.out = (float*)d_out; a.ws = (unsigned char*)d_ws;
    for (int i = 0; i < 32; ++i) a.inv_freq[i] = powf(10000.0f, -(float)i * 2.0f / 64.0f);
#if MK_N_LAUNCHES == 1
    a.ph_lo = 0; a.ph_hi = NPHASE;
    void* kargs[] = {&a};
    const hipError_t e = hipLaunchCooperativeKernel((const void*)hybrid_fwd, dim3(grid), dim3(512), kargs, LDS_BYTES, stream);
    if (e != hipSuccess) fprintf(stderr, "kernel_launch: cooperative launch failed: %s (grid %d)\n", hipGetErrorString(e), grid);
#else
    for (int k = 0; k < NPHASE; ++k) {
        a.ph_lo = k; a.ph_hi = k + 1;
        hipLaunchKernelGGL(hybrid_fwd, dim3(grid), dim3(512), LDS_BYTES, stream, a);
    }
#endif
}
```

```cpp
#include <hip/hip_runtime.h>
#include <hip/hip_cooperative_groups.h>
#include <cstdio>
#include <cstdint>
#include <cmath>
namespace cg = cooperative_groups;
#define MK_N_LAUNCHES 1
namespace pg8 {
#define PG8_LAS __attribute__((address_space(3)))
typedef unsigned short bf16_t;
typedef short bf16x8 __attribute__((ext_vector_type(8)));
typedef float f32x4 __attribute__((ext_vector_type(4)));
typedef unsigned u32x4 __attribute__((ext_vector_type(4)));
constexpr int BM = 256, BK = 64, HALF = 128, HTB = HALF * BK * 2  , STAGE_BYTES = 8 * HTB, NXCD = 8, WGM = 8;

__host__ __device__ __forceinline__ int lds_byte(int r, int c) { const int st = (r >> 4) * 2 + (c >> 5), rr = r & 15, cc = c & 31, ob = rr * 64 + cc * 2; return st * 1024 + (ob ^ (((ob >> 9) & 1) << 5)); }
__host__ __device__ __forceinline__ void stage_rc(int b, int& R, int& C) { const int st = b / 1024, sb = b % 1024, swz = sb ^ (((sb >> 9) & 1) << 5); R = (st >> 1) * 16 + swz / 64; C = (st & 1) * 32 + (swz % 64) / 2; }
__host__ __device__ __forceinline__ int perm32(int rho) { const int n = rho >> 4, i = rho & 15; return 8 * (i >> 2) + 4 * n + (i & 3); }

struct Unit { int pm, pn; };
struct Gemm { const bf16_t* A; const bf16_t* Bt; int M, N, K; };

struct StaticOrder {
    int nM, nN, nwg, G, c;
    __host__ __device__ void init(int M, int N, int G_, int c_) { nM = M / BM; nN = N / BM; nwg = nM * nN; G = G_; c = c_; }
    __host__ __device__ bool next(int i, Unit& u) const {
        const long L = (long)i * G + c; if (L >= nwg) return false;
        int wgid = (int)L; { const int q = nwg / NXCD, r = nwg % NXCD, xcd = wgid % NXCD, off = wgid / NXCD; wgid = (xcd < r ? xcd * (q + 1) : r * (q + 1) + (xcd - r) * q) + off; }
        const int nig = WGM * nN, gid = wgid / nig, fm = gid * WGM, gsz = (nM - fm) < WGM ? (nM - fm) : WGM;
        u.pm = fm + ((wgid % nig) % gsz); u.pn = (wgid % nig) / gsz; return true;
    }
    __device__ __forceinline__ void a_ready(const Unit&) const {}
    __device__ __forceinline__ void done(const Unit&) const {}
};

__device__ __forceinline__ unsigned cvt_pk_bf16(float lo, float hi) { unsigned r; asm volatile("v_cvt_pk_bf16_f32 %0, %1, %2" : "=v"(r) : "v"(lo), "v"(hi)); return r; }
typedef float f32x2 __attribute__((ext_vector_type(2)));
__device__ __forceinline__ f32x2 gelu_pk(f32x2 v) {
    const f32x2 av = __builtin_elementwise_abs(v), d = av * 0.2316418882f + 1.0f;
    f32x2 t; t.x = __builtin_amdgcn_rcpf(d.x); t.y = __builtin_amdgcn_rcpf(d.y);
    f32x2 q = t * 0.5307027145f + (-0.7265760135f); q = q * t + 0.7107068705f; q = q * t + (-0.142248368f); q = q * t + 0.127414796f; q = q * t;
    const f32x2 s = (v * v) * (-0.72134752044f);
    f32x2 e; e.x = __builtin_amdgcn_exp2f(s.x); e.y = __builtin_amdgcn_exp2f(s.y);
    const f32x2 m = v * (q * e), r = v - m;
    f32x2 o; o.x = v.x < 0.f ? m.x : r.x; o.y = v.y < 0.f ? m.y : r.y; return o;
}

template <int ACT  > struct EpiBf16 {
    static constexpr bool PERM = true, AFTER_DRAIN = false; static_assert(ACT == 0 || ACT == 1, "EpiBf16: ACT is 0 (none) or 1 (gelu_pk)");
    bf16_t* O; int ldc; const float* bias; int split_cols; size_t split_stride; float scale0;
    __device__ __forceinline__ void operator()(const f32x4 (&acc)[2][2][4][2], const Unit& u, int wr, int wc, int fr, int fq) const {
        const int row0 = u.pm * BM + wr * 64 + fr; int colt = u.pn * BM; bf16_t* base = O;
        float sc = 1.f; if (split_cols) { const int t = colt / split_cols; base += (size_t)t * split_stride; colt -= t * split_cols; if (t == 0) sc = scale0; }
        const int col0 = colt + wc * 32 + 8 * fq, bcol0 = u.pn * BM + wc * 32 + 8 * fq;
        f32x4 bv[2][2];
#pragma unroll
        for (int bj = 0; bj < 2; ++bj)
#pragma unroll
            for (int n = 0; n < 2; ++n) bv[bj][n] = bias ? *(const f32x4*)(bias + bcol0 + bj * HALF + 4 * n) : (f32x4){0.f, 0.f, 0.f, 0.f};
#pragma unroll
        for (int ai = 0; ai < 2; ++ai)
#pragma unroll
            for (int m = 0; m < 4; ++m) { bf16_t* rowp = base + (size_t)(row0 + ai * HALF + m * 16) * ldc + col0;
#pragma unroll
                for (int bj = 0; bj < 2; ++bj) { f32x4 v0 = acc[ai][bj][m][0] + bv[bj][0], v1 = acc[ai][bj][m][1] + bv[bj][1];
                    if (ACT == 1) { f32x2 a = gelu_pk((f32x2){v0[0], v0[1]}), b = gelu_pk((f32x2){v0[2], v0[3]}), c = gelu_pk((f32x2){v1[0], v1[1]}), d = gelu_pk((f32x2){v1[2], v1[3]});
                        v0 = (f32x4){a.x, a.y, b.x, b.y}; v1 = (f32x4){c.x, c.y, d.x, d.y}; }
                    v0 = v0 * sc; v1 = v1 * sc; u32x4 w; w.x = cvt_pk_bf16(v0[0], v0[1]); w.y = cvt_pk_bf16(v0[2], v0[3]); w.z = cvt_pk_bf16(v1[0], v1[1]); w.w = cvt_pk_bf16(v1[2], v1[3]);
                    *(u32x4*)(rowp + bj * HALF) = w; } }
    }
};
template <class Epi, class Sched, bool ALIGN_EPI = false, bool SP2 = false>
__device__ __forceinline__ void gemm_phase(PG8_LAS unsigned char* lds, const Gemm g, const Sched& S, const Epi& E) {
    const int tid = threadIdx.x, wid = __builtin_amdgcn_readfirstlane(tid >> 6), lane = tid & 63, wr = wid >> 2, wc = wid & 3, fr = lane & 15, fq = lane >> 4;
    const int K = g.K, nt = K / BK;
    unsigned voffA[2], voffB[2];
#pragma unroll
    for (int i = 0; i < 2; ++i) { int R, C; stage_rc(tid * 16 + i * 8192, R, C); const int Rb = Epi::PERM ? ((R & ~31) + perm32(R & 31)) : R;
        voffA[i] = (unsigned)(R * K + C) * 2u; voffB[i] = (unsigned)(Rb * K + C) * 2u; }
    const size_t kstep = (size_t)(BK * 2);
    const size_t hstep = (size_t)HALF * K * 2;
    const size_t tstep = 2 * hstep;
    const unsigned ldsw = (unsigned)wid * 1024u;
    const int aoff = lds_byte(wr * 64 + fr, fq * 8), boff = lds_byte(wc * 32 + fr, fq * 8);
#define PG8_SA(b, h) (((b) * 2 + (h)) * HTB)
#define PG8_SB(b, h) ((4 + (b) * 2 + (h)) * HTB)
#define PG8_STAGE(bufoff, gbase, voff) do { _Pragma("unroll") for (int _i = 0; _i < 2; ++_i) \
        __builtin_amdgcn_global_load_lds((const unsigned*)((const char*)(gbase) + (voff)[_i]), (PG8_LAS unsigned*)(lds + (bufoff) + ldsw + _i * 8192), 16, 0, 0); } while (0)
#define PG8_LDA(dst, b, h) do { _Pragma("unroll") for (int m = 0; m < 4; ++m) _Pragma("unroll") for (int k = 0; k < 2; ++k) dst[m][k] = *(const PG8_LAS bf16x8*)(lds + PG8_SA(b, h) + aoff + m * 2048 + k * 1024); } while (0)
#define PG8_LDB(dst, b, h) do { _Pragma("unroll") for (int n = 0; n < 2; ++n) _Pragma("unroll") for (int k = 0; k < 2; ++k) dst[n][k] = *(const PG8_LAS bf16x8*)(lds + PG8_SB(b, h) + boff + n * 2048 + k * 1024); } while (0)
#define PG8_MMA(ai, bj, At, Bt) do { __builtin_amdgcn_s_setprio(1); _Pragma("unroll") for (int m = 0; m < 4; ++m) _Pragma("unroll") for (int n = 0; n < 2; ++n) _Pragma("unroll") for (int k = 0; k < 2; ++k) \
        acc[ai][bj][m][n] = __builtin_amdgcn_mfma_f32_16x16x32_bf16(Bt[n][k], At[m][k], acc[ai][bj][m][n], 0, 0, 0); __builtin_amdgcn_s_setprio(0); } while (0)
#define PG8_WAIT_V(n) asm volatile("s_waitcnt vmcnt(" #n ")" ::: "memory")
#define PG8_WAIT_L(n) asm volatile("s_waitcnt lgkmcnt(" #n ")" ::: "memory")
#define PG8_BAR __builtin_amdgcn_s_barrier()
#define PG8_SCHED __builtin_amdgcn_sched_barrier(0)
    Unit cur, nxt; int ui = 0;
    if (!S.next(0, cur)) return;
    f32x4 acc[2][2][4][2];
#pragma unroll
    for (int a = 0; a < 2; ++a)
#pragma unroll
        for (int b = 0; b < 2; ++b)
#pragma unroll
            for (int m = 0; m < 4; ++m)
#pragma unroll
                for (int n = 0; n < 2; ++n) acc[a][b][m][n] = (f32x4){0.f, 0.f, 0.f, 0.f};
    bf16x8 At[4][2], B0[2][2], B1[2][2];
    const char* cA = (const char*)g.A + (size_t)cur.pm * tstep; const char* cB = (const char*)g.Bt + (size_t)cur.pn * tstep;
    S.a_ready(cur);
    if constexpr (SP2) {
        PG8_STAGE(PG8_SB(0, 0), cB, voffB); PG8_STAGE(PG8_SB(0, 1), cB + hstep, voffB); PG8_STAGE(PG8_SA(0, 0), cA, voffA); PG8_STAGE(PG8_SA(0, 1), cA + hstep, voffA);
        if (wr == 1) PG8_BAR;
        PG8_WAIT_V(2); PG8_BAR;
        PG8_STAGE(PG8_SB(1, 0), cB + kstep, voffB); PG8_STAGE(PG8_SA(1, 0), cA + kstep, voffA); PG8_STAGE(PG8_SB(1, 1), cB + hstep + kstep, voffB);
        PG8_WAIT_V(6); PG8_BAR;
    } else {
        PG8_STAGE(PG8_SB(0, 0), cB, voffB); PG8_STAGE(PG8_SA(0, 0), cA, voffA); PG8_STAGE(PG8_SB(0, 1), cB + hstep, voffB); PG8_STAGE(PG8_SA(0, 1), cA + hstep, voffA);
        if (wr == 1) PG8_BAR;
        PG8_WAIT_V(4); PG8_BAR;
        PG8_STAGE(PG8_SB(1, 0), cB + kstep, voffB); PG8_STAGE(PG8_SA(1, 0), cA + kstep, voffA); PG8_STAGE(PG8_SB(1, 1), cB + hstep + kstep, voffB);
        PG8_WAIT_V(6); PG8_BAR;
    }
    for (;;) {
        const bool has_next = S.next(ui + 1, nxt);
        const char* nA = has_next ? (const char*)g.A + (size_t)nxt.pm * tstep : cA; const char* nB = has_next ? (const char*)g.Bt + (size_t)nxt.pn * tstep : cB;
        for (int t = 0; t < nt; t += 2) {
            const bool last = (t == nt - 2);
            const char* a1 = cA + (size_t)(t + 1) * kstep;
            const char* a2 = last ? nA : cA + (size_t)(t + 2) * kstep; const char* b2 = last ? nB : cB + (size_t)(t + 2) * kstep;
            const char* a3 = a2 + kstep; const char* b3 = b2 + kstep;
            if (last && has_next) S.a_ready(nxt);
            if constexpr (SP2) {
            PG8_LDB(B0, 0, 0); PG8_LDB(B1, 0, 1); PG8_SCHED; PG8_LDA(At, 0, 0); PG8_STAGE(PG8_SA(1, 1), a1 + hstep, voffA);
            PG8_WAIT_V(8); PG8_WAIT_L(0); PG8_BAR; PG8_MMA(0, 0, At, B0); PG8_MMA(0, 1, At, B1); PG8_BAR; PG8_SCHED;
            PG8_LDA(At, 0, 1); PG8_STAGE(PG8_SB(0, 0), b2, voffB); PG8_STAGE(PG8_SB(0, 1), b2 + hstep, voffB); PG8_STAGE(PG8_SA(0, 0), a2, voffA);
            PG8_WAIT_V(8); PG8_WAIT_L(0); PG8_BAR; PG8_MMA(1, 0, At, B0); PG8_MMA(1, 1, At, B1); PG8_BAR; PG8_SCHED;
            PG8_LDB(B0, 1, 0); PG8_LDB(B1, 1, 1); PG8_SCHED; PG8_LDA(At, 1, 0); PG8_STAGE(PG8_SA(0, 1), a2 + hstep, voffA);
            PG8_WAIT_V(8); PG8_WAIT_L(0); PG8_BAR; PG8_MMA(0, 0, At, B0); PG8_MMA(0, 1, At, B1); PG8_BAR; PG8_SCHED;
            PG8_LDA(At, 1, 1); PG8_STAGE(PG8_SB(1, 0), b3, voffB); PG8_STAGE(PG8_SB(1, 1), b3 + hstep, voffB); PG8_STAGE(PG8_SA(1, 0), a3, voffA);
            PG8_WAIT_V(8); PG8_WAIT_L(0); PG8_BAR; PG8_MMA(1, 0, At, B0); PG8_MMA(1, 1, At, B1); PG8_BAR; PG8_SCHED;
            } else {
            PG8_LDB(B0, 0, 0); PG8_SCHED; PG8_LDA(At, 0, 0); PG8_STAGE(PG8_SA(1, 1), a1 + hstep, voffA);
            PG8_WAIT_L(8); PG8_BAR; PG8_WAIT_L(0); PG8_MMA(0, 0, At, B0); PG8_BAR; PG8_SCHED;
            PG8_LDB(B1, 0, 1); PG8_STAGE(PG8_SB(0, 0), b2, voffB);
            PG8_BAR; PG8_WAIT_L(0); PG8_MMA(0, 1, At, B1); PG8_BAR;
            PG8_LDA(At, 0, 1); PG8_STAGE(PG8_SA(0, 0), a2, voffA);
            PG8_BAR; PG8_WAIT_L(0); PG8_MMA(1, 0, At, B0); PG8_BAR; PG8_SCHED;
            PG8_STAGE(PG8_SB(0, 1), b2 + hstep, voffB);
            PG8_WAIT_V(6); PG8_BAR; PG8_MMA(1, 1, At, B1); PG8_BAR;
            PG8_LDB(B0, 1, 0); PG8_SCHED; PG8_LDA(At, 1, 0); PG8_STAGE(PG8_SA(0, 1), a2 + hstep, voffA);
            PG8_WAIT_L(8); PG8_BAR; PG8_WAIT_L(0); PG8_MMA(0, 0, At, B0); PG8_BAR; PG8_SCHED;
            PG8_LDB(B1, 1, 1); PG8_STAGE(PG8_SB(1, 0), b3, voffB);
            PG8_BAR; PG8_WAIT_L(0); PG8_MMA(0, 1, At, B1); PG8_BAR;
            PG8_LDA(At, 1, 1); PG8_STAGE(PG8_SA(1, 0), a3, voffA);
            PG8_BAR; PG8_WAIT_L(0); PG8_MMA(1, 0, At, B0); PG8_BAR; PG8_SCHED;
            PG8_STAGE(PG8_SB(1, 1), b3 + hstep, voffB);
            PG8_WAIT_V(6); PG8_BAR; PG8_MMA(1, 1, At, B1); PG8_BAR;
            }
        }
        if constexpr (ALIGN_EPI) { if (wr == 0) PG8_BAR; }
        if constexpr (!Epi::AFTER_DRAIN) { E(acc, cur, wr, wc, fr, fq); S.done(cur); }
        if (!has_next) break;
#pragma unroll
        for (int a = 0; a < 2; ++a)
#pragma unroll
            for (int b = 0; b < 2; ++b)
#pragma unroll
                for (int m = 0; m < 4; ++m)
#pragma unroll
                    for (int n = 0; n < 2; ++n) acc[a][b][m][n] = (f32x4){0.f, 0.f, 0.f, 0.f};
        cur = nxt; cA = nA; cB = nB; ++ui;
        if constexpr (ALIGN_EPI) { if (wr == 1) PG8_BAR; }
    }
    PG8_WAIT_V(0);
    if constexpr (!ALIGN_EPI) { if (wr == 0) PG8_BAR; }
    PG8_BAR;
    if constexpr (Epi::AFTER_DRAIN) { E.fused(acc, cur, wr, wc, fr, fq, lds, wid, lane); S.done(cur); }
#undef PG8_SA
#undef PG8_SB
#undef PG8_STAGE
#undef PG8_LDA
#undef PG8_LDB
#undef PG8_MMA
#undef PG8_WAIT_V
#undef PG8_WAIT_L
#undef PG8_BAR
#undef PG8_SCHED
}
}

#ifndef MK_N_LAUNCHES
#define MK_N_LAUNCHES 1
#endif
constexpr int NPHASE = 6;
constexpr int BATCH = 4, SEQ = 8192, DM = 1024, M = BATCH * SEQ;
constexpr int AW = 768, NH = 12, HD = 64, CW = 256, INW = 4096;
constexpr float NORM_EPS = 1e-6f;
constexpr float QSCALE = 0.125f * 1.4426950408889634f;

#define LAS __attribute__((address_space(3)))
typedef unsigned short bf16_t;
typedef short bf16x8 __attribute__((ext_vector_type(8)));
typedef short s16x4 __attribute__((ext_vector_type(4)));
typedef float f32x4 __attribute__((ext_vector_type(4)));
typedef float f32x16 __attribute__((ext_vector_type(16)));
typedef unsigned u32x4 __attribute__((ext_vector_type(4)));
typedef unsigned u32x2 __attribute__((ext_vector_type(2)));

constexpr size_t MiB = 1u << 20;
constexpr size_t WS_WIN = 1 * MiB, WS_WOUT = 9 * MiB, WS_ROPEC = 11 * MiB, WS_ROPES = 12 * MiB;
constexpr size_t WS_XN = 16 * MiB;
constexpr size_t WS_Q = 80 * MiB, WS_K = 128 * MiB, WS_V = 176 * MiB, WS_G = 224 * MiB;
constexpr size_t WS_U = 272 * MiB, WS_GB = 288 * MiB;
constexpr size_t WS_O = 304 * MiB;
constexpr size_t WS_LSE = 448 * MiB;
constexpr size_t WS_Y = 80 * MiB;
constexpr size_t WS_END = 456 * MiB;
constexpr size_t O_STRIDE = (size_t)M * AW, LSE_STRIDE = (size_t)M * NH;

constexpr int LDS_BYTES = 147456;

__device__ __forceinline__ float bf2f(unsigned short b) { return __uint_as_float((unsigned)b << 16); }
__device__ __forceinline__ float bflo(unsigned w) { return __uint_as_float(w << 16); }
__device__ __forceinline__ float bfhi(unsigned w) { return __uint_as_float(w & 0xffff0000u); }
__device__ __forceinline__ unsigned pk2(float lo, float hi) { return pg8::cvt_pk_bf16(lo, hi); }
__device__ __forceinline__ float silu_f(float v) { return v * __builtin_amdgcn_rcpf(1.0f + __builtin_amdgcn_exp2f(-1.4426950408889634f * v)); }
__device__ __forceinline__ float wave_sum(float v) {
#pragma unroll
    for (int o = 1; o < 64; o <<= 1) v += __shfl_xor(v, o);
    return v;
}

__host__ __device__ __forceinline__ int src_col(int j) {
    const int pn = j >> 8, jj = j & 255, bj = jj >> 7, wc = (jj >> 5) & 3;
    if (pn < 12) { const int type = pn / 3, tt = pn % 3; return type * AW + (4 * tt + wc) * 64 + 32 * bj + (jj & 31); }
    const int ct = pn - 12, fq = (jj >> 3) & 3, n = (jj >> 2) & 1, i = jj & 3;
    const int arr = (bj == 0) ? (n == 0 ? 0 : 512) : (n == 0 ? 256 : 768);
    return 4 * AW + arr + 64 * ct + 16 * wc + 4 * fq + i;
}

struct EpiIn {
    static constexpr bool PERM = true, AFTER_DRAIN = false;
    bf16_t *Q, *K, *V, *G, *U, *GB; const float* ropec; const float* ropes;
    __device__ __forceinline__ void operator()(const f32x4 (&acc)[2][2][4][2], const pg8::Unit& u, int wr, int wc, int fr, int fq) const {
        const int pn = u.pn, row0 = u.pm * 256 + wr * 64 + fr;
        if (pn < 12) {
            const int type = pn / 3, tt = pn - 3 * type;
            bf16_t* base = (type == 0) ? Q : (type == 1) ? K : (type == 2) ? V : G;
            const int col = (4 * tt + wc) * 64 + 8 * fq;
#pragma unroll
            for (int ai = 0; ai < 2; ++ai)
#pragma unroll
                for (int m = 0; m < 4; ++m) {
                    const int row = row0 + ai * 128 + m * 16;
                    f32x4 a0 = acc[ai][0][m][0], a1 = acc[ai][0][m][1], b0 = acc[ai][1][m][0], b1 = acc[ai][1][m][1];
                    if (type < 2) {
                        const int pos = row & (SEQ - 1);
                        const f32x4 c0 = *(const f32x4*)(ropec + pos * 32 + 8 * fq), c1 = *(const f32x4*)(ropec + pos * 32 + 8 * fq + 4);
                        const f32x4 s0 = *(const f32x4*)(ropes + pos * 32 + 8 * fq), s1 = *(const f32x4*)(ropes + pos * 32 + 8 * fq + 4);
                        const f32x4 x0 = a0 * c0 - b0 * s0, x1 = a1 * c1 - b1 * s1, y0 = b0 * c0 + a0 * s0, y1 = b1 * c1 + a1 * s1;
                        const float sc = (type == 0) ? QSCALE : 1.0f;
                        a0 = x0 * sc; a1 = x1 * sc; b0 = y0 * sc; b1 = y1 * sc;
                    } else if (type == 3) {
#pragma unroll
                        for (int i = 0; i < 4; ++i) { a0[i] = silu_f(a0[i]); a1[i] = silu_f(a1[i]); b0[i] = silu_f(b0[i]); b1[i] = silu_f(b1[i]); }
                    }
                    bf16_t* rp = base + (size_t)row * AW + col;
                    u32x4 w; w.x = pk2(a0[0], a0[1]); w.y = pk2(a0[2], a0[3]); w.z = pk2(a1[0], a1[1]); w.w = pk2(a1[2], a1[3]);
                    *(u32x4*)rp = w;
                    w.x = pk2(b0[0], b0[1]); w.y = pk2(b0[2], b0[3]); w.z = pk2(b1[0], b1[1]); w.w = pk2(b1[2], b1[3]);
                    *(u32x4*)(rp + 32) = w;
                }
        } else {
            const int ch = 64 * (pn - 12) + 16 * wc + 4 * fq;
#pragma unroll
            for (int ai = 0; ai < 2; ++ai)
#pragma unroll
                for (int m = 0; m < 4; ++m) {
                    const int row = row0 + ai * 128 + m * 16;
                    const f32x4 vh = acc[ai][0][m][0], vc = acc[ai][0][m][1], vb = acc[ai][1][m][0], vg = acc[ai][1][m][1];
                    const f32x4 uu = vc * vh;
                    f32x4 gb;
#pragma unroll
                    for (int i = 0; i < 4; ++i) gb[i] = vb[i] * silu_f(vg[i]);
                    u32x2 w; w.x = pk2(uu[0], uu[1]); w.y = pk2(uu[2], uu[3]);
                    *(u32x2*)(U + (size_t)row * CW + ch) = w;
                    w.x = pk2(gb[0], gb[1]); w.y = pk2(gb[2], gb[3]);
                    *(u32x2*)(GB + (size_t)row * CW + ch) = w;
                }
        }
    }
};

struct EpiY {
    static constexpr bool PERM = true, AFTER_DRAIN = false;
    bf16_t* O; int ldc;
    __device__ __forceinline__ void operator()(const f32x4 (&acc)[2][2][4][2], const pg8::Unit& u, int wr, int wc, int fr, int fq) const {
        const int row0 = u.pm * 256 + wr * 64 + fr, col0 = u.pn * 256 + wc * 32 + 8 * fq;
#pragma unroll
        for (int ai = 0; ai < 2; ++ai)
#pragma unroll
            for (int m = 0; m < 4; ++m) { bf16_t* rowp = O + (size_t)(row0 + ai * 128 + m * 16) * ldc + col0;
#pragma unroll
                for (int bj = 0; bj < 2; ++bj) { const f32x4 v0 = acc[ai][bj][m][0], v1 = acc[ai][bj][m][1];
                    u32x4 w; w.x = pk2(v0[0], v0[1]); w.y = pk2(v0[2], v0[3]); w.z = pk2(v1[0], v1[1]); w.w = pk2(v1[2], v1[3]);
                    *(u32x4*)(rowp + bj * 128) = w; } }
    }
};


struct RepOrder : pg8::StaticOrder {
    int rep;
    __device__ bool next(int i, pg8::Unit& u) const {
        const long L0 = (long)i * G + c; if (L0 >= (long)rep * nwg) return false;
        int wgid = (int)(L0 % nwg); { const int q = nwg / pg8::NXCD, r = nwg % pg8::NXCD, xcd = wgid % pg8::NXCD, off = wgid / pg8::NXCD; wgid = (xcd < r ? xcd * (q + 1) : r * (q + 1) + (xcd - r) * q) + off; }
        const int nig = pg8::WGM * nN, gid = wgid / nig, fm = gid * pg8::WGM, gsz = (nM - fm) < pg8::WGM ? (nM - fm) : pg8::WGM;
        u.pm = fm + ((wgid % nig) % gsz); u.pn = (wgid % nig) / gsz; return true;
    }
};

namespace att {
constexpr int NK = 384, KCH = NK * 16, VH = NK * 64;
constexpr int LDS_K = 0, LDS_V = 8 * KCH, LDS_TOTAL = LDS_V + 2 * VH;
__device__ __forceinline__ int crow(int r, int hi) { return (r & 3) + 8 * (r >> 2) + 4 * hi; }
typedef short v4i16_t __attribute__((ext_vector_type(4)));
__device__ __forceinline__ s16x4 vtr(const LAS unsigned char* p) { return __builtin_bit_cast(s16x4, __builtin_amdgcn_ds_read_tr16_b64_v4i16((LAS v4i16_t*)p)); }

__device__ __forceinline__ void attn_unit(LAS unsigned char* lds, const bf16_t* Q, const bf16_t* K, const bf16_t* V, bf16_t* O, float* LSE, int dil, int b, int h, int res, int qb) {
    const int tid = threadIdx.x, lane = tid & 63, r32 = lane & 31, hi = lane >> 5;
    const int w = __builtin_amdgcn_readfirstlane(tid >> 6);
    const int m0 = qb * 256;
    const size_t rowb = (size_t)b * SEQ;
#pragma unroll
    for (int i = 0; i < 6; ++i) {
        int pos = m0 - 128 + 64 * i + lane; pos = pos < 0 ? 0 : pos;
        const bf16_t* src = K + (rowb + (size_t)pos * dil + res) * AW + h * HD + 8 * w;
        __builtin_amdgcn_global_load_lds((const unsigned*)src, (LAS unsigned*)(lds + LDS_K + w * KCH + 64 * i * 16), 16, 0, 0);
    }
#pragma unroll
    for (int i = 0; i < 6; ++i) {
        int pos = m0 - 128 + 64 * i + 16 * (w & 3) + (lane >> 2); pos = pos < 0 ? 0 : pos;
        const bf16_t* src = V + (rowb + (size_t)pos * dil + res) * AW + h * HD + (w >> 2) * 32 + (lane & 3) * 8;
        __builtin_amdgcn_global_load_lds((const unsigned*)src, (LAS unsigned*)(lds + LDS_V + (w >> 2) * VH + (64 * i + 16 * (w & 3)) * 64), 16, 0, 0);
    }
    const size_t qrow = rowb + (size_t)(m0 + 32 * w + r32) * dil + res;
    bf16x8 qf[4];
#pragma unroll
    for (int d0 = 0; d0 < 4; ++d0) qf[d0] = *(const bf16x8*)(Q + qrow * AW + h * HD + 16 * d0 + 8 * hi);
    asm volatile("s_waitcnt vmcnt(0)" ::: "memory");
    __syncthreads();
    f32x16 s[5];
#pragma unroll
    for (int j = 0; j < 5; ++j) {
        f32x16 a = {};
#pragma unroll
        for (int d0 = 0; d0 < 4; ++d0) {
            const bf16x8 kf = *(const LAS bf16x8*)(lds + LDS_K + (2 * d0 + hi) * KCH + (32 * (w + j) + r32) * 16);
            a = __builtin_amdgcn_mfma_f32_32x32x16_bf16(kf, qf[d0], a, 0, 0, 0);
        }
        s[j] = a;
    }
    const bool firstblk = (m0 == 0);
    float mx = -INFINITY;
#pragma unroll
    for (int j = 0; j < 5; ++j) {
        const bool dead = firstblk && (w + j) < 4;
#pragma unroll
        for (int r = 0; r < 16; ++r) {
            const int kk = crow(r, hi);
            bool ok = !dead;
            if (j == 0) ok = ok && (kk >= r32);
            if (j == 4) ok = ok && (kk <= r32);
            const float v = ok ? s[j][r] : -INFINITY;
            s[j][r] = v; mx = fmaxf(mx, v);
        }
    }
    mx = fmaxf(mx, __shfl_xor(mx, 32));
    float l = 0.f;
#pragma unroll
    for (int j = 0; j < 5; ++j)
#pragma unroll
        for (int r = 0; r < 16; ++r) { const float p = __builtin_amdgcn_exp2f(s[j][r] - mx); s[j][r] = p; l += p; }
    l += __shfl_xor(l, 32);
    f32x16 o[2]; o[0] = f32x16{}; o[1] = f32x16{};
    const int cgp = (lane >> 4) & 1, q4 = (lane & 15) >> 2, p4 = lane & 3;
    const LAS unsigned char* vbase = lds + LDS_V + (4 * hi + q4) * 64 + (16 * cgp + 4 * p4) * 2;
#pragma unroll
    for (int j = 0; j < 5; ++j)
#pragma unroll
        for (int s2 = 0; s2 < 2; ++s2) {
            u32x4 pw; pw.x = pk2(s[j][8 * s2 + 0], s[j][8 * s2 + 1]); pw.y = pk2(s[j][8 * s2 + 2], s[j][8 * s2 + 3]);
            pw.z = pk2(s[j][8 * s2 + 4], s[j][8 * s2 + 5]); pw.w = pk2(s[j][8 * s2 + 6], s[j][8 * s2 + 7]);
            const bf16x8 pf = __builtin_bit_cast(bf16x8, pw);
#pragma unroll
            for (int dh = 0; dh < 2; ++dh) {
                const LAS unsigned char* vp = vbase + dh * VH + (32 * (w + j) + 16 * s2) * 64;
                const s16x4 lo = vtr(vp), hh = vtr(vp + 8 * 64);
                const bf16x8 vf = (bf16x8){lo[0], lo[1], lo[2], lo[3], hh[0], hh[1], hh[2], hh[3]};
                o[dh] = __builtin_amdgcn_mfma_f32_32x32x16_bf16(vf, pf, o[dh], 0, 0, 0);
            }
        }
    const float inv = 1.0f / l;
    bf16_t* op = O + qrow * AW + h * HD;
#pragma unroll
    for (int dh = 0; dh < 2; ++dh)
#pragma unroll
        for (int g = 0; g < 4; ++g) {
            u32x2 wv; wv.x = pk2(o[dh][4 * g] * inv, o[dh][4 * g + 1] * inv); wv.y = pk2(o[dh][4 * g + 2] * inv, o[dh][4 * g + 3] * inv);
            *(u32x2*)(op + 32 * dh + 8 * g + 4 * hi) = wv;
        }
    if (hi == 0) LSE[qrow * NH + h] = mx + __builtin_amdgcn_logf(l);
    __syncthreads();
}
}

#define GAS __attribute__((address_space(1)))
#define XB_TMO      128
#define XB_XCNT(j)  (256  + 64 * (j))
#define XB_XSUB(j)  (1280 + 64 * (j))
#define XB_XGEN(j)  (2304 + 64 * (j))
#define XB_TOP      3328
#define XB_TOPGEN   3392
#define XCD_BAR_WORDS 3456
#define XB_SPIN_CAP (1u << 18)

__device__ __forceinline__ unsigned xb_ld(unsigned* p)              { return __hip_atomic_load(p, __ATOMIC_RELAXED, __HIP_MEMORY_SCOPE_AGENT); }
__device__ __forceinline__ unsigned xb_add(unsigned* p, unsigned v) { return __hip_atomic_fetch_add(p, v, __ATOMIC_RELAXED, __HIP_MEMORY_SCOPE_AGENT); }
__device__ __forceinline__ unsigned xb_xcc_id() { return (unsigned)__builtin_amdgcn_s_getreg((3 << 11) | 20) & 0xFu; }
#define XB_SPIN(cond, bar) do { unsigned _sp = 0; while (cond) { __builtin_amdgcn_s_sleep(1); \
    if ((++_sp & 255u) == 0u) { if (xb_ld(&(bar)[XB_TMO])) break; if (_sp > XB_SPIN_CAP) { atomicAdd(&(bar)[XB_TMO], 1u); break; } } } } while (0)

struct XcdBarrier {
    unsigned* bar; unsigned x;
    volatile LAS unsigned* st;
};

__device__ __forceinline__ XcdBarrier xcd_barrier_post(unsigned* bar, volatile LAS unsigned* st) {
    XcdBarrier b; b.bar = bar; b.x = xb_xcc_id(); b.st = st;
    if (threadIdx.x == 0) (void)xb_add(&bar[XB_XCNT(b.x)], 1u);
    return b;
}
__device__ __forceinline__ void xcd_barrier_complete(unsigned* bar, unsigned x, unsigned& nloc, unsigned& nx) {
    const unsigned G = gridDim.x * gridDim.y * gridDim.z;
    unsigned sum, cnt, mine, sp = 0u;
    for (;;) {
        sum = 0u; cnt = 0u; mine = 0u;
#pragma unroll
        for (unsigned j = 0; j < 16; ++j) { const unsigned c = xb_ld(&bar[XB_XCNT(j)]); sum += c; cnt += (c > 0u) ? 1u : 0u; mine = (j == x) ? c : mine; }
        if (sum == G) break;
        __builtin_amdgcn_s_sleep(1);
        if ((++sp & 255u) == 0u) { if (xb_ld(&bar[XB_TMO])) break; if (sp > XB_SPIN_CAP) { atomicAdd(&bar[XB_TMO], 1u); break; } }
    }
    nloc = mine > 0u ? mine : 1u; nx = cnt > 0u ? cnt : 1u;
}

__device__ __forceinline__ void xcd_barrier(const XcdBarrier& b) {
    asm volatile("s_waitcnt vmcnt(0)" ::: "memory");
    __syncthreads();
    if (threadIdx.x == 0) {
        unsigned* bar = b.bar;
        __builtin_amdgcn_s_waitcnt(0);
        unsigned nloc = b.st[0], nx = b.st[1];
        if (nloc == 0u) { xcd_barrier_complete(bar, b.x, nloc, nx); b.st[0] = nloc; b.st[1] = nx; }
        const unsigned old = xb_add(&bar[XB_XSUB(b.x)], 1u);
        const unsigned gen = old / nloc;
        if (old + 1u == (gen + 1u) * nloc) {
            __builtin_amdgcn_fence(__ATOMIC_RELEASE, "agent");
            asm volatile("s_waitcnt vmcnt(0)" ::: "memory");
            const unsigned og = xb_add(&bar[XB_TOP], 1u);
            const unsigned tg = og / nx;
            if (og + 1u == (tg + 1u) * nx) xb_add(&bar[XB_TOPGEN], 1u);
            else XB_SPIN(xb_ld(&bar[XB_TOPGEN]) == tg, bar);
            __builtin_amdgcn_fence(__ATOMIC_ACQUIRE, "agent");
            xb_add(&bar[XB_XGEN(b.x)], 1u);
            asm volatile("s_waitcnt vmcnt(0)" ::: "memory");
        } else {
            XB_SPIN(xb_ld(&bar[XB_XGEN(b.x)]) == gen, bar);
            __builtin_amdgcn_fence(__ATOMIC_ACQUIRE, "agent");
            asm volatile("s_waitcnt vmcnt(0)" ::: "memory");
        }
    }
    __syncthreads();
}


struct Args { const float* x; const float* g_pre; const float* w_in; const float* conv_w; const float* w_out; const float* g_post; float* out; unsigned char* ws; float inv_freq[32]; int ph_lo, ph_hi; };

__device__ __forceinline__ void transpose_item(const float* W, int N, bf16_t* WT, int K, int nblk, bool perm, LAS float* scr, int item, int lane) {
    const int kb = item / nblk, nb = item % nblk, k0 = 64 * kb, n0 = 32 * nb;
    const int sc = perm ? src_col(n0 + (lane & 31)) : n0 + (lane & 31);
#pragma unroll 8
    for (int i = 0; i < 32; ++i) { const int kk = 2 * i + (lane >> 5); scr[kk * 33 + (lane & 31)] = W[(size_t)(k0 + kk) * N + sc]; }
    asm volatile("s_waitcnt lgkmcnt(0)" ::: "memory");
    const int c = lane & 7;
#pragma unroll
    for (int j = 0; j < 4; ++j) { const int n = (lane >> 3) + 8 * j; const LAS float* s = scr + (8 * c) * 33 + n;
        u32x4 o; o.x = pk2(s[0 * 33], s[1 * 33]); o.y = pk2(s[2 * 33], s[3 * 33]); o.z = pk2(s[4 * 33], s[5 * 33]); o.w = pk2(s[6 * 33], s[7 * 33]);
        *(u32x4*)(WT + (size_t)(n0 + n) * K + k0 + 8 * c) = o; }
    asm volatile("s_waitcnt lgkmcnt(0)" ::: "memory");
}

__global__ void __launch_bounds__(512, 2) hybrid_fwd(Args args) {
    extern __shared__ __attribute__((aligned(16))) unsigned char lds_raw[];
    LAS unsigned char* lds = (LAS unsigned char*)lds_raw;
    const int tid = threadIdx.x, lane = tid & 63, wave = __builtin_amdgcn_readfirstlane(tid >> 6);
    const int G = gridDim.x, bx = blockIdx.x;
    unsigned char* ws = args.ws;
    bf16_t* Win_t = (bf16_t*)(ws + WS_WIN); bf16_t* Wout_t = (bf16_t*)(ws + WS_WOUT);
    float* ropec = (float*)(ws + WS_ROPEC); float* ropes = (float*)(ws + WS_ROPES);
    bf16_t* XN = (bf16_t*)(ws + WS_XN); bf16_t* MIX = (bf16_t*)(ws + WS_XN);
    bf16_t* Qb = (bf16_t*)(ws + WS_Q); bf16_t* Kb = (bf16_t*)(ws + WS_K); bf16_t* Vb = (bf16_t*)(ws + WS_V); bf16_t* Gb = (bf16_t*)(ws + WS_G);
    bf16_t* Ub = (bf16_t*)(ws + WS_U); bf16_t* GBb = (bf16_t*)(ws + WS_GB);
    bf16_t* Ob = (bf16_t*)(ws + WS_O); float* LSEb = (float*)(ws + WS_LSE); bf16_t* Yb = (bf16_t*)(ws + WS_Y);
    const int lo = args.ph_lo, hi_ph = args.ph_hi;
    volatile LAS unsigned* bst = (volatile LAS unsigned*)(lds + 131072 + 64);
    if (tid < 4) bst[tid] = 0u;
    __syncthreads();
    XcdBarrier bar = xcd_barrier_post((unsigned*)ws + 1024, bst);
#ifndef PROBE_REP
#define PROBE_REP -1
#endif
#define IN(k) (lo <= (k) && (k) < hi_ph)
#define NREP(k) ((PROBE_REP == (k)) ? 2 : 1)
#ifndef PROBE_TS
#define PROBE_TS -1
#endif
#define STAMP(k) do { if (PROBE_TS >= 0 && bx == 0 && tid == 0) ((volatile unsigned long long*)ws)[k] = __builtin_amdgcn_s_memrealtime(); } while (0)
#define SEAM(k) do { if ((IN(k) && IN((k) + 1)) || (PROBE_TS >= 0 && (k) == NPHASE - 1)) xcd_barrier(bar); STAMP((k) + 1); } while (0)
    STAMP(0);

    if (IN(0)) for (int rep_ = 0; rep_ < NREP(0); ++rep_) {
        LAS float* scr = (LAS float*)(lds + wave * 16384);
        const int gw = bx * 8 + wave, NGW = G * 8;
        constexpr int I_IN = (DM / 64) * (INW / 32), I_OUT = (DM / 64) * (DM / 32);
        for (int it = gw; it < I_IN + I_OUT; it += NGW) {
            if (it < I_IN) transpose_item(args.w_in, INW, Win_t, DM, INW / 32, true, scr, it, lane);
            else transpose_item(args.w_out, DM, Wout_t, DM, DM / 32, false, scr, it - I_IN, lane);
        }
        for (int e = bx * 512 + tid; e < SEQ * 32; e += G * 512) {
            const int pos = e >> 5, dd = e & 31;
            const float angf = (float)pos * args.inv_freq[dd];
            const double xa = (double)angf;
            const double nq = rint(xa * 0.63661977236758134308);
            const double r = (xa - nq * 1.57079632679489655800) - nq * 6.123233995736766e-17;
            const double z = r * r;
            const double sn = r * (1.0 - z / 6.0 * (1.0 - z / 20.0 * (1.0 - z / 42.0 * (1.0 - z / 72.0 * (1.0 - z / 110.0 * (1.0 - z / 156.0))))));
            const double cs = 1.0 - z / 2.0 * (1.0 - z / 12.0 * (1.0 - z / 30.0 * (1.0 - z / 56.0 * (1.0 - z / 90.0 * (1.0 - z / 132.0 * (1.0 - z / 182.0))))));
            const int qd = ((int)nq) & 3;
            const double sv = (qd == 0) ? sn : (qd == 1) ? cs : (qd == 2) ? -sn : -cs;
            const double cv = (qd == 0) ? cs : (qd == 1) ? -sn : (qd == 2) ? -cs : sn;
            ropec[e] = (float)cv; ropes[e] = (float)sv;
        }
        for (int m = gw; m < M; m += NGW) {
            const f32x4* xr = (const f32x4*)(args.x + (size_t)m * DM) + lane;
            f32x4 v[4]; float ss = 0.f;
#pragma unroll
            for (int j = 0; j < 4; ++j) { v[j] = xr[64 * j]; ss += (v[j].x * v[j].x + v[j].y * v[j].y) + (v[j].z * v[j].z + v[j].w * v[j].w); }
            const float rstd = 1.0f / sqrtf(wave_sum(ss) * (1.0f / DM) + NORM_EPS);
            unsigned long long* o8 = (unsigned long long*)(XN + (size_t)m * DM) + lane;
#pragma unroll
            for (int j = 0; j < 4; ++j) { const f32x4 g = ((const f32x4*)args.g_pre)[lane + 64 * j];
                o8[64 * j] = (unsigned long long)pk2(v[j].x * rstd * g.x, v[j].y * rstd * g.y) | ((unsigned long long)pk2(v[j].z * rstd * g.z, v[j].w * rstd * g.w) << 32); }
        }
        __syncthreads();
    }
    SEAM(0);

    if (IN(1)) {
        pg8::Gemm g{XN, Win_t, M, INW, DM}; RepOrder S; S.init(M, INW, G, bx); S.rep = NREP(1);
        EpiIn E{Qb, Kb, Vb, Gb, Ub, GBb, ropec, ropes};
        pg8::gemm_phase<EpiIn, RepOrder, true, true>(lds, g, S, E);
    }
    SEAM(1);

    if (IN(2)) for (int rep_ = 0; rep_ < NREP(2); ++rep_) {
        constexpr int NUNIT = 3 * BATCH * NH * 32;
        for (int u = bx; u < NUNIT; u += G) {
            const int p = u / (BATCH * NH * 32), rem = u % (BATCH * NH * 32), bh = rem >> 5, idx = rem & 31;
            const int b = bh / NH, h = bh % NH;
            const int dil = (p == 0) ? 1 : (p == 1) ? 4 : 16;
            const int nqb = 32 / dil;
            const int res = idx / nqb, qb = idx % nqb;
            att::attn_unit(lds, Qb, Kb, Vb, Ob + (size_t)p * O_STRIDE, LSEb + (size_t)p * LSE_STRIDE, dil, b, h, res, qb);
        }
    }
    SEAM(2);

    if (IN(3)) for (int rep_ = 0; rep_ < NREP(3); ++rep_) {
        const int c8 = tid & 127;
        for (int row = bx * 4 + (tid >> 7); row < M; row += G * 4) {
            if (c8 < 96) {
                const int h = c8 >> 3, col = c8 * 8;
                const float l0 = LSEb[(size_t)row * NH + h], l1 = LSEb[LSE_STRIDE + (size_t)row * NH + h], l2 = LSEb[2 * LSE_STRIDE + (size_t)row * NH + h];
                const float mx = fmaxf(l0, fmaxf(l1, l2));
                float w0 = __builtin_amdgcn_exp2f(l0 - mx), w1 = __builtin_amdgcn_exp2f(l1 - mx), w2 = __builtin_amdgcn_exp2f(l2 - mx);
                const float inv = 1.0f / (w0 + w1 + w2); w0 *= inv; w1 *= inv; w2 *= inv;
                const size_t off = (size_t)row * AW + col;
                const u32x4 a = *(const u32x4*)(Ob + off), bq = *(const u32x4*)(Ob + O_STRIDE + off), c = *(const u32x4*)(Ob + 2 * O_STRIDE + off), g = *(const u32x4*)(Gb + off);
                u32x4 o;
#pragma unroll
                for (int i = 0; i < 4; ++i) {
                    const float lo_ = (w0 * bflo(a[i]) + w1 * bflo(bq[i]) + w2 * bflo(c[i])) * bflo(g[i]);
                    const float hi_ = (w0 * bfhi(a[i]) + w1 * bfhi(bq[i]) + w2 * bfhi(c[i])) * bfhi(g[i]);
                    o[i] = pk2(lo_, hi_);
                }
                *(u32x4*)(MIX + (size_t)row * DM + col) = o;
            } else {
                const int ch = (c8 - 96) * 8, pos = row & (SEQ - 1);
                const u32x4 z = {0u, 0u, 0u, 0u};
                const u32x4 u0 = *(const u32x4*)(Ub + (size_t)row * CW + ch);
                const u32x4 u1 = (pos >= 1) ? *(const u32x4*)(Ub + (size_t)(row - 1) * CW + ch) : z;
                const u32x4 u2 = (pos >= 2) ? *(const u32x4*)(Ub + (size_t)(row - 2) * CW + ch) : z;
                const u32x4 gb = *(const u32x4*)(GBb + (size_t)row * CW + ch);
                const float* cw = args.conv_w + ch;
                u32x4 o;
#pragma unroll
                for (int i = 0; i < 4; ++i) {
                    const float lo_ = bflo(gb[i]) * (cw[2 * i] * bflo(u2[i]) + cw[CW + 2 * i] * bflo(u1[i]) + cw[2 * CW + 2 * i] * bflo(u0[i]));
                    const float hi_ = bfhi(gb[i]) * (cw[2 * i + 1] * bfhi(u2[i]) + cw[CW + 2 * i + 1] * bfhi(u1[i]) + cw[2 * CW + 2 * i + 1] * bfhi(u0[i]));
                    o[i] = pk2(lo_, hi_);
                }
                *(u32x4*)(MIX + (size_t)row * DM + AW + ch) = o;
            }
        }
    }
    SEAM(3);

    if (IN(4)) {
        pg8::Gemm g{MIX, Wout_t, M, DM, DM}; RepOrder S; S.init(M, DM, G, bx); S.rep = NREP(4);
        EpiY E{Yb, DM};
        pg8::gemm_phase<EpiY, RepOrder, true, true>(lds, g, S, E);
    }
    SEAM(4);

    if (IN(5)) for (int rep_ = 0; rep_ < NREP(5); ++rep_) {
        const int gw = bx * 8 + wave, NGW = G * 8;
        for (int m = gw; m < M; m += NGW) {
            const u32x4* yr = (const u32x4*)(Yb + (size_t)m * DM) + lane;
            const u32x4 y0 = yr[0], y1 = yr[64];
            float ss = 0.f;
#pragma unroll
            for (int i = 0; i < 4; ++i) { const float a = bflo(y0[i]), b_ = bfhi(y0[i]), c = bflo(y1[i]), d = bfhi(y1[i]); ss += (a * a + b_ * b_) + (c * c + d * d); }
            const float rstd = 1.0f / sqrtf(wave_sum(ss) * (1.0f / DM) + NORM_EPS);
#pragma unroll
            for (int j = 0; j < 2; ++j) {
                const u32x4 y = j ? y1 : y0;
                const int col = 8 * lane + 512 * j;
                const f32x4* xp = (const f32x4*)(args.x + (size_t)m * DM + col);
                const f32x4* gp = (const f32x4*)(args.g_post + col);
                f32x4* outp = (f32x4*)(args.out + (size_t)m * DM + col);
                const f32x4 xa = xp[0], xb = xp[1], ga = gp[0], gb = gp[1];
                f32x4 oa, ob;
                oa.x = xa.x + bflo(y[0]) * rstd * ga.x; oa.y = xa.y + bfhi(y[0]) * rstd * ga.y; oa.z = xa.z + bflo(y[1]) * rstd * ga.z; oa.w = xa.w + bfhi(y[1]) * rstd * ga.w;
                ob.x = xb.x + bflo(y[2]) * rstd * gb.x; ob.y = xb.y + bfhi(y[2]) * rstd * gb.y; ob.z = xb.z + bflo(y[3]) * rstd * gb.z; ob.w = xb.w + bfhi(y[3]) * rstd * gb.w;
                outp[0] = oa; outp[1] = ob;
            }
        }
    }
    SEAM(5);
    if (PROBE_TS >= 0 && bx == 0 && tid == 0) {
        const unsigned long long t0 = ((volatile unsigned long long*)ws)[PROBE_TS >= NPHASE ? 0 : PROBE_TS], t1 = ((volatile unsigned long long*)ws)[PROBE_TS >= NPHASE ? NPHASE : PROBE_TS + 1];
        args.out[0] = (float)(t1 - t0) * 0.01f;
    }
#undef IN
#undef SEAM
}

extern "C" void kernel_launch(void* const* d_in, const int* in_sizes, int n_in, void* d_out, int out_size, void* d_ws, size_t ws_size, hipStream_t stream) {
    static int grid = 0;
    if (grid == 0) {
        if (n_in != 6 || in_sizes[0] != M * DM || out_size != M * DM || ws_size < WS_END) { fprintf(stderr, "kernel_launch: unexpected shapes (n_in %d, in0 %d, out %d, ws %zu); nothing launched\n", n_in, n_in > 0 ? in_sizes[0] : -1, out_size, ws_size); grid = -1; return; }
        int dev = 0, cus = 0, per_cu = 0;
        if (hipGetDevice(&dev) != hipSuccess || hipDeviceGetAttribute(&cus, hipDeviceAttributeMultiprocessorCount, dev) != hipSuccess) { grid = -1; return; }
        if (hipFuncSetAttribute((const void*)hybrid_fwd, hipFuncAttributeMaxDynamicSharedMemorySize, LDS_BYTES) != hipSuccess) { fprintf(stderr, "kernel_launch: hipFuncSetAttribute failed\n"); grid = -1; return; }
        if (hipOccupancyMaxActiveBlocksPerMultiprocessor(&per_cu, (const void*)hybrid_fwd, 512, LDS_BYTES) != hipSuccess || per_cu < 1) { fprintf(stderr, "kernel_launch: occupancy query reports %d blocks per CU\n", per_cu); per_cu = 1; }
        (void)hipGetLastError();
        grid = cus;
    }
    if (grid < 0) return;
    if (hipMemsetAsync(d_ws, 0, 65536, stream) != hipSuccess) { fprintf(stderr, "kernel_launch: hipMemsetAsync failed\n"); return; }
    Args a{};
    a.x = (const float*)d_in[0]; a.g_pre = (const float*)d_in[1]; a.w_in = (const float*)d_in[2]; a.conv_w = (const float*)d_in[3];
    a.w_out = (const float*)d_in[4]; a.g_post = (const float*)d_in[5]; a.out = (float*)d_out; a.ws = (unsigned char*)d_ws;
    for (int i = 0; i < 32; ++i) a.inv_freq[i] = powf(10000.0f, -(float)i * 2.0f / 64.0f);
#if MK_N_LAUNCHES == 1
    a.ph_lo = 0; a.ph_hi = NPHASE;
    void* kargs[] = {&a};
    const hipError_t e = hipLaunchCooperativeKernel((const void*)hybrid_fwd, dim3(grid), dim3(512), kargs, LDS_BYTES, stream);
    if (e != hipSuccess) fprintf(stderr, "kernel_launch: cooperative launch failed: %s (grid %d)\n", hipGetErrorString(e), grid);
#else
    for (int k = 0; k < NPHASE; ++k) {
        a.ph_lo = k; a.ph_hi = k + 1;
        hipLaunchKernelGGL(hybrid_fwd, dim3(grid), dim3(512), LDS_BYTES, stream, a);
    }
#endif
}
```
